# Optimizing an MI355X kernel written in HIP

```python
import math
import jax, jax.numpy as jnp
from jax import lax
import numpy as np

D_MODEL = 1024
BATCH = 2
SEQ = 8192
DEPTH = 4

CTX_LEN = 256
GRID_W = 64

GMLP_HEADS = 4
GMLP_HEAD_DIM = 64
GMLP_CHUNK = 128
W_A = GMLP_HEADS * GMLP_HEAD_DIM

DIFF_HEADS = 4
DIFF_HEAD_DIM = 64
DIFF_V_DIM = 2 * DIFF_HEAD_DIM
W_B = DIFF_HEADS * DIFF_V_DIM

CONV_GROUPS = 4
CONV_GROUP_DIM = 64
CONV_WIDTH = 3
W_C = CONV_GROUPS * CONV_GROUP_DIM

D_MIX = W_A + W_B + W_C
D_IN = 3 * W_A + 4 * W_B + 4 * W_C
KV_START = 3 * W_A + W_B
KV_END = KV_START + 2 * W_B

Q_BLOCK = 128
ROPE_BASE = 10000.0
ROPE_PAIRS = DIFF_HEAD_DIM // 4
EPS = 1e-6

kernel_name = "hybrid_parallel_heads_dit_trunk"


def rmsnorm(x, g):
    xf = x.astype(jnp.float32)
    y = xf * lax.rsqrt(jnp.mean(xf * xf, axis=-1, keepdims=True) + EPS)
    return (y * g.astype(jnp.float32)).astype(x.dtype)


def adaln(cond, w_mod, b_mod):
    m = jax.nn.silu(cond) @ w_mod + b_mod
    return jnp.split(m, 3, axis=-1)


def split_cols(p):
    widths = (W_A, W_A, W_A, W_B, W_B, W_B, W_B, W_C, W_C, W_C, W_C)
    idx = [int(i) for i in np.cumsum(widths)[:-1]]
    return jnp.split(p, idx, axis=-1)


def axial_rope_tables(rows):
    row = jnp.broadcast_to(jnp.arange(rows)[:, None], (rows, GRID_W)).reshape(-1).astype(jnp.float32)
    col = jnp.broadcast_to(jnp.arange(GRID_W)[None, :], (rows, GRID_W)).reshape(-1).astype(jnp.float32)
    inv = ROPE_BASE ** (-jnp.arange(ROPE_PAIRS, dtype=jnp.float32) / ROPE_PAIRS)
    ang = jnp.stack([row[:, None] * inv, col[:, None] * inv], axis=1)
    return jnp.cos(ang), jnp.sin(ang)


def apply_rope(x, cos, sin):
    xs = x.reshape(x.shape[:-1] + (2, 2, ROPE_PAIRS))
    x1, x2 = xs[..., 0, :], xs[..., 1, :]
    c = cos[None, :, None, None]
    s = sin[None, :, None, None]
    out = jnp.stack([x1 * c - x2 * s, x2 * c + x1 * s], axis=-2)
    return out.reshape(x.shape).astype(x.dtype)


def short_conv3(x, w, b):
    xp = jnp.pad(x, ((0, 0), (1, 1), (0, 0)))
    return xp[:, :-2] * w[0] + xp[:, 1:-1] * w[1] + xp[:, 2:] * w[2] + b


def chunk_sgu(u, v, g, w_s, b_s):
    bsz, length, _ = v.shape
    v = rmsnorm(v, g)
    vc = v.reshape(bsz, length // GMLP_CHUNK, GMLP_CHUNK, GMLP_HEADS, GMLP_HEAD_DIM)
    mixed = jnp.einsum('hpq,bnqhd->bnphd', w_s, vc) + b_s.T[None, None, :, :, None]
    return u * mixed.reshape(bsz, length, W_A)


def diff_attention(q, k_all, v_all, lam):
    bsz, length = q.shape[:2]
    nb = length // Q_BLOCK
    scale = 1.0 / math.sqrt(DIFF_HEAD_DIM)
    qb = q.reshape(bsz, nb, Q_BLOCK, DIFF_HEADS, 2, DIFF_HEAD_DIM).transpose(1, 0, 2, 3, 4, 5)

    def block(qblk):
        s = jnp.einsum('bqhmd,bkhmd->bhmqk', qblk, k_all).astype(jnp.float32) * scale
        p = jax.nn.softmax(s, axis=-1)
        a = p[:, :, 0] - lam * p[:, :, 1]
        return jnp.einsum('bhqk,bkhe->bqhe', a.astype(v_all.dtype), v_all)

    o = lax.map(block, qb)
    return o.transpose(1, 0, 2, 3, 4).reshape(bsz, length, DIFF_HEADS, DIFF_V_DIM)


def mixer(parts, k_all, v_all, rope, lam, lam_init, w_out, sgu_g, sgu_w, sgu_b, subln_g, conv_w, conv_b):
    au, av, az, bq, _, _, bz, cb, cc, cx, cz = parts
    bsz, length, _ = au.shape
    ya = chunk_sgu(jax.nn.gelu(au), jax.nn.gelu(av), sgu_g, sgu_w, sgu_b) * jax.nn.silu(az)
    q = bq.reshape(bsz, length, DIFF_HEADS, 2, DIFF_HEAD_DIM)
    if rope is not None:
        q = apply_rope(q, rope[0], rope[1])
    ob = rmsnorm(diff_attention(q, k_all, v_all, lam), subln_g) * (1.0 - lam_init)
    yb = ob.reshape(bsz, length, W_B) * jax.nn.silu(bz)
    yc = cb * short_conv3(cc * cx, conv_w, conv_b) * jax.nn.silu(cz)
    return jnp.concatenate([ya, yb, yc], axis=-1) @ w_out


def setup_inputs(seed: int = 0) -> dict:
    key = jax.random.key(seed)
    ks = jax.random.split(key, 24)
    f32 = jnp.float32
    nrm = lambda k, shape, s: jax.random.normal(k, shape, f32) * s
    return {
        "x": nrm(ks[0], (BATCH, SEQ, D_MODEL), 1.0),
        "c": nrm(ks[1], (BATCH, D_MODEL), 1.0),
        "ctx": nrm(ks[2], (BATCH, CTX_LEN, D_MODEL), 1.0),
        "c_ctx": nrm(ks[3], (D_MODEL,), 1.0),
        "w_mod": nrm(ks[4], (DEPTH, D_MODEL, 3 * D_MODEL), 0.5 * D_MODEL ** -0.5),
        "b_mod": nrm(ks[5], (DEPTH, 3 * D_MODEL), 0.02),
        "norm_g": 1.0 + nrm(ks[6], (DEPTH, D_MODEL), 0.02),
        "w_in": nrm(ks[7], (DEPTH, D_MODEL, D_IN), D_MODEL ** -0.5),
        "w_out": nrm(ks[8], (DEPTH, D_MIX, D_MODEL), D_MIX ** -0.5),
        "sgu_norm_g": 1.0 + nrm(ks[9], (DEPTH, W_A), 0.02),
        "sgu_w": nrm(ks[10], (DEPTH, GMLP_HEADS, GMLP_CHUNK, GMLP_CHUNK), GMLP_CHUNK ** -0.5),
        "sgu_b": 1.0 + nrm(ks[11], (DEPTH, GMLP_HEADS, GMLP_CHUNK), 0.02),
        "lambda_q1": nrm(ks[12], (DEPTH, DIFF_HEAD_DIM), 0.1),
        "lambda_k1": nrm(ks[13], (DEPTH, DIFF_HEAD_DIM), 0.1),
        "lambda_q2": nrm(ks[14], (DEPTH, DIFF_HEAD_DIM), 0.1),
        "lambda_k2": nrm(ks[15], (DEPTH, DIFF_HEAD_DIM), 0.1),
        "subln_g": 1.0 + nrm(ks[16], (DEPTH, DIFF_V_DIM), 0.02),
        "conv_w": nrm(ks[17], (DEPTH, CONV_WIDTH, W_C), CONV_WIDTH ** -0.5),
        "conv_b": nrm(ks[18], (DEPTH, W_C), 0.02),
        "final_g": 1.0 + nrm(ks[19], (D_MODEL,), 0.02),
    }


def reference(x, c, ctx, c_ctx, w_mod, b_mod, norm_g, w_in, w_out, sgu_norm_g, sgu_w, sgu_b,
              lambda_q1, lambda_k1, lambda_q2, lambda_k2, subln_g, conv_w, conv_b, final_g):
    bsz, length, _ = x.shape
    ctx_len = ctx.shape[1]
    rows = length // GRID_W
    cos, sin = axial_rope_tables(rows)
    for l in range(DEPTH):
        lam_init = 0.8 - 0.6 * math.exp(-0.3 * l)
        update_ctx = l < DEPTH - 1
        lam = (jnp.exp(jnp.sum(lambda_q1[l].astype(jnp.float32) * lambda_k1[l].astype(jnp.float32)))
               - jnp.exp(jnp.sum(lambda_q2[l].astype(jnp.float32) * lambda_k2[l].astype(jnp.float32)))
               + lam_init)
        sh, sc, gt = adaln(c, w_mod[l], b_mod[l])
        sh_c, sc_c, gt_c = adaln(c_ctx, w_mod[l], b_mod[l])
        h = rmsnorm(x, norm_g[l]) * (1.0 + sc[:, None]) + sh[:, None]
        hc = rmsnorm(ctx, norm_g[l]) * (1.0 + sc_c) + sh_c

        parts = split_cols(h @ w_in[l])
        k_lat = apply_rope(parts[4].reshape(bsz, length, DIFF_HEADS, 2, DIFF_HEAD_DIM), cos, sin)
        v_lat = parts[5].reshape(bsz, length, DIFF_HEADS, DIFF_V_DIM)
        if update_ctx:
            cparts = split_cols(hc @ w_in[l])
            kc_flat, vc_flat = cparts[4], cparts[5]
        else:
            kc_flat, vc_flat = jnp.split(hc @ w_in[l][:, KV_START:KV_END], 2, axis=-1)
        k_ctx = kc_flat.reshape(bsz, ctx_len, DIFF_HEADS, 2, DIFF_HEAD_DIM)
        v_ctx = vc_flat.reshape(bsz, ctx_len, DIFF_HEADS, DIFF_V_DIM)
        k_all = jnp.concatenate([k_ctx, k_lat], axis=1)
        v_all = jnp.concatenate([v_ctx, v_lat], axis=1)

        lw = (w_out[l], sgu_norm_g[l], sgu_w[l], sgu_b[l], subln_g[l], conv_w[l], conv_b[l])
        y_lat = mixer(parts, k_all, v_all, (cos, sin), lam, lam_init, *lw)
        if update_ctx:
            y_ctx = mixer(cparts, k_ctx, v_ctx, None, lam, lam_init, *lw)
            ctx = ctx + gt_c * y_ctx
        x = x + gt[:, None] * y_lat
    return rmsnorm(x, final_g)
```

```cpp
#include <hip/hip_runtime.h>
#include <hip/hip_cooperative_groups.h>
#include <cstdio>
#include <cmath>
namespace cg = cooperative_groups;


constexpr int DM = 1024, NBATCH = 2, SEQ = 8192, DEPTH = 4, CTXL = 256;
constexpr int NLAT = NBATCH * SEQ, NCTX = NBATCH * CTXL, NROW = NLAT + NCTX;
constexpr int DIN = 3840;
constexpr int COL_AU = 0, COL_AV = 256, COL_AZ = 512, COL_Q = 768, COL_K = 1280, COL_V = 1792, COL_BZ = 2304, COL_CB = 2816, COL_CC = 3072, COL_CX = 3328, COL_CZ = 3584;
constexpr int YA = 0, YB = 256, YC = 768;
constexpr float EPS = 1e-6f;
constexpr int NPHASE = 2 + 4 * DEPTH;

typedef unsigned short bf16_t;
typedef short bf16x8 __attribute__((ext_vector_type(8)));
typedef short s16x4 __attribute__((ext_vector_type(4)));
typedef float f32x4 __attribute__((ext_vector_type(4)));
typedef float f32x16 __attribute__((ext_vector_type(16)));
typedef unsigned u32x4 __attribute__((ext_vector_type(4)));
typedef unsigned u32x2 __attribute__((ext_vector_type(2)));

struct Params {
    const float* x; const float* c; const float* ctx; const float* c_ctx; const float* w_mod; const float* b_mod; const float* norm_g;
    const float* w_in; const float* w_out; const float* sgu_g; const float* sgu_w; const float* sgu_b;
    const float* lq1; const float* lk1; const float* lq2; const float* lk2; const float* subln_g; const float* conv_w; const float* conv_b; const float* final_g;
    float* xlat;
    float* xctx;
    bf16_t* WinT;
    bf16_t* WoutT;
    float* mod;
    float* rope;
    float* lam;
    unsigned* bar;
    bf16_t* HY;
    bf16_t* P;
};

typedef const __attribute__((address_space(4))) Params CParams;
__device__ __forceinline__ CParams& params_l() { unsigned long long k = (unsigned long long)__builtin_amdgcn_kernarg_segment_ptr(); asm volatile("" : "+s"(k)); return *(CParams*)k; }
__device__ __forceinline__ int tid_l(int wv) { int t; asm volatile("v_mbcnt_lo_u32_b32 %0, -1, 0\n\tv_mbcnt_hi_u32_b32 %0, -1, %0\n\tv_lshl_or_b32 %0, %1, 6, %0" : "=&v"(t) : "s"(wv)); return t; }
__device__ __forceinline__ int bid_l() { int t = blockIdx.x; asm volatile("" : "+s"(t)); return t; }
__device__ __forceinline__ float shx(float v, int lane, int m) { return __int_as_float(__builtin_amdgcn_ds_bpermute((lane ^ m) << 2, __float_as_int(v))); }
#define DPP_ADD(v, CTRL) ((v) + __int_as_float(__builtin_amdgcn_update_dpp(0, __float_as_int(v), (CTRL), 0xf, 0xf, false)))
__device__ __forceinline__ float row16_sum(float v) { v = DPP_ADD(v, 0xB1); v = DPP_ADD(v, 0x4E); v = DPP_ADD(v, 0x141); v = DPP_ADD(v, 0x140); return v; }
__device__ __forceinline__ float swap32(float v, int hi) { auto rr = __builtin_amdgcn_permlane32_swap(__float_as_uint(v), __float_as_uint(v), false, false); return __uint_as_float(hi ? rr[0] : rr[1]); }
__device__ __forceinline__ float bf2f(short s) { return __uint_as_float(((unsigned)(unsigned short)s) << 16); }
__device__ __forceinline__ unsigned cvtpk(float lo, float hi) { unsigned r; asm volatile("v_cvt_pk_bf16_f32 %0, %1, %2" : "=v"(r) : "v"(lo), "v"(hi)); return r; }
__device__ __forceinline__ float silu_f(float x) { return x * __builtin_amdgcn_rcpf(1.f + __builtin_amdgcn_exp2f(-1.4426950408889634f * x)); }
__device__ __forceinline__ float gelu_f(float x) { const float z = x * (1.f + 0.044715f * x * x); return x * __builtin_amdgcn_rcpf(1.f + __builtin_amdgcn_exp2f(-2.3022081985f * z)); }

namespace pg8 {
#define PG8_LAS __attribute__((address_space(3)))
constexpr int BM = 256, BK = 64, HALF = 128, HTB = HALF * BK * 2, STAGE_BYTES = 8 * HTB, NXCD = 8, WGM = 8;
__device__ __forceinline__ int lds_byte(int r, int c) { const int st = (r >> 4) * 2 + (c >> 5), rr = r & 15, cc = c & 31, ob = rr * 64 + cc * 2; return st * 1024 + (ob ^ (((ob >> 9) & 1) << 5)); }
__device__ __forceinline__ void stage_rc(int b, int& R, int& C) { const int st = b / 1024, sb = b % 1024, swz = sb ^ (((sb >> 9) & 1) << 5); R = (st >> 1) * 16 + swz / 64; C = (st & 1) * 32 + (swz % 64) / 2; }
__device__ __forceinline__ int perm32(int rho) { const int n = rho >> 4, i = rho & 15; return 8 * (i >> 2) + 4 * n + (i & 3); }
struct Unit { int pm, pn; };
struct Gemm { const bf16_t* A; const bf16_t* Bt; int M, N, K; };
struct StaticOrder {
    int nM, nN, nwg, G, c;
    __device__ void init(int M, int N, int G_, int c_) { nM = M / BM; nN = N / BM; nwg = nM * nN; G = G_; c = c_; }
    __device__ bool next(int i, Unit& u) const {
        const long L = (long)i * G + c; if (L >= nwg) return false;
        int wgid = (int)L; { const int q = nwg / NXCD, r = nwg % NXCD, xcd = wgid % NXCD, off = wgid / NXCD; wgid = (xcd < r ? xcd * (q + 1) : r * (q + 1) + (xcd - r) * q) + off; }
        const int nig = WGM * nN, gid = wgid / nig, fm = gid * WGM, gsz = (nM - fm) < WGM ? (nM - fm) : WGM;
        u.pm = fm + ((wgid % nig) % gsz); u.pn = (wgid % nig) / gsz; return true;
    }
    __device__ __forceinline__ void a_ready(const Unit&) const {}
    __device__ __forceinline__ void done(const Unit&) const {}
};

template <class Epi, class Sched>
__device__ __forceinline__ void gemm_phase(PG8_LAS unsigned char* lds, const Gemm g, const Sched& S, const Epi& E, int wv) {
    const int tid = tid_l(wv), wid = __builtin_amdgcn_readfirstlane(tid >> 6), lane = tid & 63, wr = wid >> 2, wc = wid & 3, fr = lane & 15, fq = lane >> 4;
    const int K = g.K, nt = K / BK;
    unsigned voffA[2], voffB[2];
#pragma unroll
    for (int i = 0; i < 2; ++i) { int R, C; stage_rc(tid * 16 + i * 8192, R, C); const int Rb = Epi::PERM ? ((R & ~31) + perm32(R & 31)) : R;
        voffA[i] = (unsigned)(R * K + C) * 2u; voffB[i] = (unsigned)(Rb * K + C) * 2u; }
    const size_t kstep = (size_t)(BK * 2);
    const size_t hstep = (size_t)HALF * K * 2;
    const size_t tstep = 2 * hstep;
    const unsigned ldsw = (unsigned)wid * 1024u;
    const int aoff = lds_byte(wr * 64 + fr, fq * 8), boff = lds_byte(wc * 32 + fr, fq * 8);
#define PG8_SA(b, h) (((b) * 2 + (h)) * HTB)
#define PG8_SB(b, h) ((4 + (b) * 2 + (h)) * HTB)
#define PG8_STAGE(bufoff, gbase, voff) do { _Pragma("unroll") for (int _i = 0; _i < 2; ++_i) \
        __builtin_amdgcn_global_load_lds((const unsigned*)((const char*)(gbase) + (voff)[_i]), (PG8_LAS unsigned*)(lds + (bufoff) + ldsw + _i * 8192), 16, 0, 0); } while (0)
#define PG8_LDA(dst, b, h) do { _Pragma("unroll") for (int m = 0; m < 4; ++m) _Pragma("unroll") for (int k = 0; k < 2; ++k) dst[m][k] = *(const PG8_LAS bf16x8*)(lds + PG8_SA(b, h) + aoff + m * 2048 + k * 1024); } while (0)
#define PG8_LDB(dst, b, h) do { _Pragma("unroll") for (int n = 0; n < 2; ++n) _Pragma("unroll") for (int k = 0; k < 2; ++k) dst[n][k] = *(const PG8_LAS bf16x8*)(lds + PG8_SB(b, h) + boff + n * 2048 + k * 1024); } while (0)
#define PG8_MMA(ai, bj, At, Bt) do { __builtin_amdgcn_s_setprio(1); _Pragma("unroll") for (int m = 0; m < 4; ++m) _Pragma("unroll") for (int n = 0; n < 2; ++n) _Pragma("unroll") for (int k = 0; k < 2; ++k) \
        acc[ai][bj][m][n] = __builtin_amdgcn_mfma_f32_16x16x32_bf16(Bt[n][k], At[m][k], acc[ai][bj][m][n], 0, 0, 0); __builtin_amdgcn_s_setprio(0); } while (0)
#define PG8_WAIT_V(n) asm volatile("s_waitcnt vmcnt(" #n ")" ::: "memory")
#define PG8_WAIT_L(n) asm volatile("s_waitcnt lgkmcnt(" #n ")" ::: "memory")
#define PG8_BAR __builtin_amdgcn_s_barrier()
#define PG8_SCHED __builtin_amdgcn_sched_barrier(0)
    Unit cur, nxt; int ui = 0;
    if (!S.next(0, cur)) return;
    f32x4 acc[2][2][4][2];
#pragma unroll
    for (int a = 0; a < 2; ++a)
#pragma unroll
        for (int b = 0; b < 2; ++b)
#pragma unroll
            for (int m = 0; m < 4; ++m)
#pragma unroll
                for (int n = 0; n < 2; ++n) acc[a][b][m][n] = (f32x4){0.f, 0.f, 0.f, 0.f};
    bf16x8 At[4][2], B0[2][2], B1[2][2];
    const char* cA = (const char*)g.A + (size_t)cur.pm * tstep; const char* cB = (const char*)g.Bt + (size_t)cur.pn * tstep;
    S.a_ready(cur);
    PG8_STAGE(PG8_SB(0, 0), cB, voffB); PG8_STAGE(PG8_SA(0, 0), cA, voffA); PG8_STAGE(PG8_SB(0, 1), cB + hstep, voffB); PG8_STAGE(PG8_SA(0, 1), cA + hstep, voffA);
    if (wr == 1) PG8_BAR;
    PG8_WAIT_V(4); PG8_BAR;
    PG8_STAGE(PG8_SB(1, 0), cB + kstep, voffB); PG8_STAGE(PG8_SA(1, 0), cA + kstep, voffA); PG8_STAGE(PG8_SB(1, 1), cB + hstep + kstep, voffB);
    PG8_WAIT_V(6); PG8_BAR;
    for (;;) {
        const bool has_next = S.next(ui + 1, nxt);
        const char* nA = has_next ? (const char*)g.A + (size_t)nxt.pm * tstep : cA; const char* nB = has_next ? (const char*)g.Bt + (size_t)nxt.pn * tstep : cB;
        for (int t = 0; t < nt; t += 2) {
            const bool last = (t == nt - 2);
            const char* a1 = cA + (size_t)(t + 1) * kstep;
            const char* a2 = last ? nA : cA + (size_t)(t + 2) * kstep; const char* b2 = last ? nB : cB + (size_t)(t + 2) * kstep;
            const char* a3 = a2 + kstep; const char* b3 = b2 + kstep;
            if (last && has_next) S.a_ready(nxt);
            PG8_LDB(B0, 0, 0); PG8_SCHED; PG8_LDA(At, 0, 0); PG8_STAGE(PG8_SA(1, 1), a1 + hstep, voffA);
            PG8_WAIT_L(8); PG8_BAR; PG8_WAIT_L(0); PG8_MMA(0, 0, At, B0); PG8_BAR; PG8_SCHED;
            PG8_LDB(B1, 0, 1); PG8_STAGE(PG8_SB(0, 0), b2, voffB);
            PG8_BAR; PG8_WAIT_L(0); PG8_MMA(0, 1, At, B1); PG8_BAR;
            PG8_LDA(At, 0, 1); PG8_STAGE(PG8_SA(0, 0), a2, voffA);
            PG8_BAR; PG8_WAIT_L(0); PG8_MMA(1, 0, At, B0); PG8_BAR; PG8_SCHED;
            PG8_STAGE(PG8_SB(0, 1), b2 + hstep, voffB);
            PG8_WAIT_V(6); PG8_BAR; PG8_MMA(1, 1, At, B1); PG8_BAR;
            PG8_LDB(B0, 1, 0); PG8_SCHED; PG8_LDA(At, 1, 0); PG8_STAGE(PG8_SA(0, 1), a2 + hstep, voffA);
            PG8_WAIT_L(8); PG8_BAR; PG8_WAIT_L(0); PG8_MMA(0, 0, At, B0); PG8_BAR; PG8_SCHED;
            PG8_LDB(B1, 1, 1); PG8_STAGE(PG8_SB(1, 0), b3, voffB);
            PG8_BAR; PG8_WAIT_L(0); PG8_MMA(0, 1, At, B1); PG8_BAR;
            PG8_LDA(At, 1, 1); PG8_STAGE(PG8_SA(1, 0), a3, voffA);
            PG8_BAR; PG8_WAIT_L(0); PG8_MMA(1, 0, At, B0); PG8_BAR; PG8_SCHED;
            PG8_STAGE(PG8_SB(1, 1), b3 + hstep, voffB);
            PG8_WAIT_V(6); PG8_BAR; PG8_MMA(1, 1, At, B1); PG8_BAR;
        }
        E(acc, cur, wr, wc, fr, fq); S.done(cur);
        if (!has_next) break;
#pragma unroll
        for (int a = 0; a < 2; ++a)
#pragma unroll
            for (int b = 0; b < 2; ++b)
#pragma unroll
                for (int m = 0; m < 4; ++m)
#pragma unroll
                    for (int n = 0; n < 2; ++n) acc[a][b][m][n] = (f32x4){0.f, 0.f, 0.f, 0.f};
        cur = nxt; cA = nA; cB = nB; ++ui;
    }
    PG8_WAIT_V(0);
    if (wr == 0) PG8_BAR;
    PG8_BAR;
#undef PG8_SA
#undef PG8_SB
#undef PG8_STAGE
#undef PG8_LDA
#undef PG8_LDB
#undef PG8_MMA
#undef PG8_WAIT_V
#undef PG8_WAIT_L
#undef PG8_BAR
#undef PG8_SCHED
}
}

constexpr float at_QSCALE = 0.125f * 1.4426950408889634f;
struct EpiIn {
    static constexpr bool PERM = true;
    bf16_t* O; const float* rope;
    __device__ __forceinline__ void operator()(const f32x4 (&acc)[2][2][4][2], const pg8::Unit& u, int wr, int wc, int fr, int fq) const {
        const int pn = u.pn;
        const int row0 = u.pm * 256 + wr * 64 + fr, col0 = pn * 256 + wc * 32 + 8 * fq;
        const int fuse = (pn == 0 || pn == 2) ? 1 : (pn == 11 || pn == 14) ? 2 : (pn == 12 || pn == 13) ? 3 : 0;
        const int fcol = (fuse == 1 ? COL_AU + (pn == 2 ? 128 : 0) : fuse == 2 ? COL_CB + (pn == 14 ? 128 : 0) : COL_CC + (pn == 13 ? 128 : 0)) + wc * 32 + 8 * fq;
        const int act = (pn == 1) ? 1 : (pn == 9 || pn == 10) ? 2 : (pn >= 3 && pn <= 6 && u.pm < 64) ? 3 : 0;
        const int axis = wc & 1; const float sgn = fq < 2 ? -1.f : 1.f; const int p0 = 8 * (fq & 1), lane = fq * 16 + fr;
        f32x4 rc0[4], rc1[4], rs0[4], rs1[4];
#pragma unroll
        for (int ai = 0; ai < 2; ++ai)
#pragma unroll
            for (int m = 0; m < 4; ++m) {
                const int row = row0 + ai * 128 + m * 16;
                bf16_t* rowp = O + (size_t)row * DIN + col0;
                f32x4 c0 = {1.f, 1.f, 1.f, 1.f}, c1 = c0, s0 = {0.f, 0.f, 0.f, 0.f}, s1 = s0;
                if (act == 3) {
                    if (axis ? (ai == 0) : (m == 0)) { const int t = row & (SEQ - 1); const int pos = axis ? (t & 63) : (t >> 6); const float* tp = rope + pos * 16 + p0;
                        const f32x4 tc0 = *(const f32x4*)tp, tc1 = *(const f32x4*)(tp + 4), ts0 = *(const f32x4*)(tp + 2048) * sgn, ts1 = *(const f32x4*)(tp + 2052) * sgn;
                        if (axis) { rc0[m] = tc0; rc1[m] = tc1; rs0[m] = ts0; rs1[m] = ts1; } else { rc0[0] = tc0; rc1[0] = tc1; rs0[0] = ts0; rs1[0] = ts1; } }
                    const int sel = axis ? m : 0; c0 = rc0[sel]; c1 = rc1[sel]; s0 = rs0[sel]; s1 = rs1[sel]; }
                if (fuse) {
                    f32x4 a0 = acc[ai][0][m][0], a1 = acc[ai][0][m][1], b0 = acc[ai][1][m][0], b1 = acc[ai][1][m][1];
                    if (fuse == 1) {
#pragma unroll
                        for (int j = 0; j < 4; ++j) { a0[j] = gelu_f(a0[j]) * silu_f(b0[j]); a1[j] = gelu_f(a1[j]) * silu_f(b1[j]); } }
                    else if (fuse == 2) {
#pragma unroll
                        for (int j = 0; j < 4; ++j) { a0[j] *= silu_f(b0[j]); a1[j] *= silu_f(b1[j]); } }
                    else { a0 *= b0; a1 *= b1; }
                    u32x4 w; w.x = cvtpk(a0[0], a0[1]); w.y = cvtpk(a0[2], a0[3]); w.z = cvtpk(a1[0], a1[1]); w.w = cvtpk(a1[2], a1[3]);
                    *(u32x4*)(O + (size_t)row * DIN + fcol) = w;
                    continue; }
#pragma unroll
                for (int bj = 0; bj < 2; ++bj) {
                    f32x4 v0 = acc[ai][bj][m][0], v1 = acc[ai][bj][m][1];
                    if (act == 1) {
#pragma unroll
                        for (int j = 0; j < 4; ++j) { v0[j] = gelu_f(v0[j]); v1[j] = gelu_f(v1[j]); } }
                    else if (act == 2) {
#pragma unroll
                        for (int j = 0; j < 4; ++j) { v0[j] = silu_f(v0[j]); v1[j] = silu_f(v1[j]); } }
                    else if (act == 3) {
                        f32x4 q0, q1;
#pragma unroll
                        for (int j = 0; j < 4; ++j) { q0[j] = swap32(v0[j], fq >> 1); q1[j] = swap32(v1[j], fq >> 1); }
                        v0 = v0 * c0 + q0 * s0; v1 = v1 * c1 + q1 * s1; }
                    if (pn == 3 || pn == 4) { v0 *= at_QSCALE; v1 *= at_QSCALE; }
                    u32x4 w; w.x = cvtpk(v0[0], v0[1]); w.y = cvtpk(v0[2], v0[3]); w.z = cvtpk(v1[0], v1[1]); w.w = cvtpk(v1[2], v1[3]);
                    *(u32x4*)(rowp + bj * 128) = w; }
            }
    }
};
struct EpiOut {
    static constexpr bool PERM = false;
    const float* src_lat; const float* src_ctx; float* dst_lat; float* dst_ctx; const float* modl;
    __device__ __forceinline__ void operator()(const f32x4 (&acc)[2][2][4][2], const pg8::Unit& u, int wr, int wc, int fr, int fq) const {
        const int cnd = u.pm < 32 ? 0 : u.pm < 64 ? 1 : 2;
        const int lrow0 = (u.pm < 64 ? u.pm * 256 : (u.pm - 64) * 256) + wr * 64 + fr, col0 = u.pn * 256 + wc * 32 + 4 * fq;
        const float* sp = (u.pm < 64 ? src_lat : src_ctx); float* dp = (u.pm < 64 ? dst_lat : dst_ctx);
        const float* gate = modl + cnd * 3072 + 2048 + col0;
        f32x4 gv[2][2];
#pragma unroll
        for (int bj = 0; bj < 2; ++bj)
#pragma unroll
            for (int n = 0; n < 2; ++n) gv[bj][n] = *(const f32x4*)(gate + bj * 128 + n * 16);
#pragma unroll
        for (int ai = 0; ai < 2; ++ai) {
            f32x4 xs[4][2][2];
#pragma unroll
            for (int m = 0; m < 4; ++m) { const size_t ro = (size_t)(lrow0 + ai * 128 + m * 16) * DM + col0;
#pragma unroll
                for (int bj = 0; bj < 2; ++bj)
#pragma unroll
                    for (int n = 0; n < 2; ++n) xs[m][bj][n] = *(const f32x4*)(sp + ro + bj * 128 + n * 16); }
#pragma unroll
            for (int m = 0; m < 4; ++m) { const size_t ro = (size_t)(lrow0 + ai * 128 + m * 16) * DM + col0;
#pragma unroll
                for (int bj = 0; bj < 2; ++bj)
#pragma unroll
                    for (int n = 0; n < 2; ++n) *(f32x4*)(dp + ro + bj * 128 + n * 16) = xs[m][bj][n] + gv[bj][n] * acc[ai][bj][m][n]; }
        }
    }
};

namespace at {
constexpr int KVBLK = 64;
constexpr float QSCALE = 0.125f * 1.4426950408889634f;
constexpr float THR2 = 8.f * 1.4426950408889634f;
constexpr int SHM_V = KVBLK * 128 * 2, SHM_K = KVBLK * 128 * 2;
#define KSWZ(row, colB) ((row) * 256 + ((colB) ^ (((row) & 15) << 4)))
#define SBAR() __builtin_amdgcn_sched_barrier(0)
__device__ __forceinline__ int crow(int r, int hi) { return (r & 3) + 8 * (r >> 2) + 4 * hi; }
__device__ __forceinline__ void partialSM(f32x16& p0, f32x16& p1, float& m_reg, float& mn, float& alpha) {
    float pmax = p0[0];
#pragma unroll
    for (int r = 1; r < 16; ++r) pmax = fmaxf(pmax, p0[r]);
#pragma unroll
    for (int r = 0; r < 16; ++r) pmax = fmaxf(pmax, p1[r]);
    { auto rr = __builtin_amdgcn_permlane32_swap(__float_as_uint(pmax), __float_as_uint(pmax), false, false);
      pmax = fmaxf(__uint_as_float(rr[0]), __uint_as_float(rr[1])); }
    if (__builtin_expect(__all(pmax - m_reg <= THR2), 1)) { mn = m_reg; alpha = 1.f; }
    else { mn = fmaxf(m_reg, pmax); alpha = __builtin_amdgcn_exp2f(m_reg - mn); m_reg = mn; }
#pragma unroll
    for (int r = 0; r < 16; ++r) p0[r] -= mn;
#pragma unroll
    for (int r = 0; r < 16; ++r) p1[r] -= mn;
#pragma unroll
    for (int r = 0; r < 16; ++r) p0[r] = __builtin_amdgcn_exp2f(p0[r]);
}
__device__ __forceinline__ void finishSM(f32x16& p0, f32x16& p1, float alpha, float& l_reg, bf16x8& pa0, bf16x8& pa1, bf16x8& pa2, bf16x8& pa3) {
#pragma unroll
    for (int r = 0; r < 16; ++r) p1[r] = __builtin_amdgcn_exp2f(p1[r]);
    float ps = 0;
#pragma unroll
    for (int r = 0; r < 16; ++r) ps += p0[r];
#pragma unroll
    for (int r = 0; r < 16; ++r) ps += p1[r];
    { auto rr = __builtin_amdgcn_permlane32_swap(__float_as_uint(ps), __float_as_uint(ps), false, false);
      ps = __uint_as_float(rr[0]) + __uint_as_float(rr[1]); }
    l_reg = l_reg * alpha + ps;
#define PK4(P, BASE, OUT) do { unsigned a0 = cvtpk(P[BASE + 0], P[BASE + 1]), a1 = cvtpk(P[BASE + 2], P[BASE + 3]);   \
    unsigned b0 = cvtpk(P[BASE + 4], P[BASE + 5]), b1 = cvtpk(P[BASE + 6], P[BASE + 7]);                              \
    auto r0 = __builtin_amdgcn_permlane32_swap(a0, b0, false, false); auto r1 = __builtin_amdgcn_permlane32_swap(a1, b1, false, false); \
    u32x4 w = {r0[0], r1[0], r0[1], r1[1]}; OUT = *reinterpret_cast<bf16x8*>(&w); } while (0)
    PK4(p0, 0, pa0); PK4(p0, 8, pa1); PK4(p1, 0, pa2); PK4(p1, 8, pa3);
#undef PK4
}
__device__ __forceinline__ void qkt(f32x16& p0, f32x16& p1, const char* Ks, const bf16x8* qr, int r32, int hi, int mcolB) {
    p0 = f32x16{}; p1 = f32x16{};
#pragma unroll
    for (int d0 = 0; d0 < 4; ++d0) { const int cb = mcolB + (d0 * 16 + hi * 8) * 2;
        const bf16x8 b0 = *reinterpret_cast<const bf16x8*>(Ks + KSWZ(r32, cb));
        const bf16x8 b1 = *reinterpret_cast<const bf16x8*>(Ks + KSWZ(32 + r32, cb));
        p0 = __builtin_amdgcn_mfma_f32_32x32x16_bf16(b0, qr[d0], p0, 0, 0, 0);
        p1 = __builtin_amdgcn_mfma_f32_32x32x16_bf16(b1, qr[d0], p1, 0, 0, 0); }
}
__device__ __forceinline__ int v_st(int k, int c) { const int kk = (k & ~0xC) | ((k & 4) << 1) | ((k & 8) >> 1); return ((kk >> 3) * 4 + (c >> 5)) * 512 + ((kk & 7) * 32 + (c & 31)) * 2; }
__device__ __forceinline__ int v_rd_base(int lane) { return ((lane & 3) << 3) | (((lane >> 2) & 3) << 6) | (((lane >> 4) & 1) << 5) | (((lane >> 5) & 1) << 8); }
constexpr int v_rd_off(int d0, int ks, int half) { return d0 * 512 + ks * 4096 + half * 2048; }
template <int OFF> __device__ __forceinline__ s16x4 tr_read(int vb) {
    s16x4 r; asm volatile("ds_read_b64_tr_b16 %0, %1 offset:%2" : "=&v"(r) : "v"(vb), "i"(OFF) : "memory"); return r;
}
template <int D0> __device__ __forceinline__ void pv_one(f32x16& od, int vb, bf16x8 pa0, bf16x8 pa1, bf16x8 pa2, bf16x8 pa3) {
    const s16x4 l0 = tr_read<v_rd_off(D0, 0, 0)>(vb), h0 = tr_read<v_rd_off(D0, 0, 1)>(vb), l1 = tr_read<v_rd_off(D0, 1, 0)>(vb), h1 = tr_read<v_rd_off(D0, 1, 1)>(vb);
    const s16x4 l2 = tr_read<v_rd_off(D0, 2, 0)>(vb), h2 = tr_read<v_rd_off(D0, 2, 1)>(vb), l3 = tr_read<v_rd_off(D0, 3, 0)>(vb), h3 = tr_read<v_rd_off(D0, 3, 1)>(vb);
    asm volatile("s_waitcnt lgkmcnt(0)" ::: "memory"); SBAR();
#define PK(L, H) (bf16x8){L[0], L[1], L[2], L[3], H[0], H[1], H[2], H[3]}
    od = __builtin_amdgcn_mfma_f32_32x32x16_bf16(pa0, PK(l0, h0), od, 0, 0, 0);
    od = __builtin_amdgcn_mfma_f32_32x32x16_bf16(pa1, PK(l1, h1), od, 0, 0, 0);
    od = __builtin_amdgcn_mfma_f32_32x32x16_bf16(pa2, PK(l2, h2), od, 0, 0, 0);
    od = __builtin_amdgcn_mfma_f32_32x32x16_bf16(pa3, PK(l3, h3), od, 0, 0, 0);
#undef PK
}
__device__ __forceinline__ void pv_d0(f32x16* o, int vb, bf16x8 pa0, bf16x8 pa1, bf16x8 pa2, bf16x8 pa3) {
    pv_one<0>(o[0], vb, pa0, pa1, pa2, pa3); pv_one<1>(o[1], vb, pa0, pa1, pa2, pa3); pv_one<2>(o[2], vb, pa0, pa1, pa2, pa3); pv_one<3>(o[3], vb, pa0, pa1, pa2, pa3);
}

__device__ __forceinline__ void attn_epilogue(f32x16* o, float l_full, const bf16_t* __restrict__ Pb, bf16_t* __restrict__ Yb, int qrow0, int h, const float* __restrict__ lamp, const float* __restrict__ subg, char* lds, float* li_l, int wv) {
    const float lam = lamp[0], obs = lamp[DEPTH];
    const int tid = tid_l(wv), wid = tid >> 6, lane = tid & 63, r32 = lane & 31, hi = lane >> 5, rg = wid & 3, mm = wid >> 2;
    if (hi == 0) li_l[r32] = l_full; asm volatile("s_waitcnt lgkmcnt(0)" ::: "memory");
    float rli[16];
#pragma unroll
    for (int r = 0; r < 16; ++r) rli[r] = __builtin_amdgcn_rcpf(li_l[crow(r, hi)]);
    float* cbuf = (float*)lds + rg * 4096 + lane;
    bf16x8 gz[4];
#pragma unroll
    for (int jj = 0; jj < 4; ++jj) { const int c = tid + 512 * jj, row = c >> 4, col8 = (c & 15) * 8;
        gz[jj] = *reinterpret_cast<const bf16x8*>(Pb + (size_t)(qrow0 + row) * DIN + COL_BZ + h * 128 + col8); }
    if (mm == 1) {
#pragma unroll
        for (int d0 = 0; d0 < 4; ++d0)
#pragma unroll
            for (int r = 0; r < 16; ++r) cbuf[(d0 * 16 + r) * 64] = -lam * o[d0][r] * rli[r];
    }
    __syncthreads();
    if (mm == 0) {
        float ss[16];
#pragma unroll
        for (int r = 0; r < 16; ++r) ss[r] = 0.f;
#pragma unroll
        for (int d0 = 0; d0 < 4; ++d0)
#pragma unroll
            for (int r = 0; r < 16; ++r) { const float v = o[d0][r] * rli[r] + cbuf[(d0 * 16 + r) * 64]; o[d0][r] = v; ss[r] += v * v; }
#pragma unroll
        for (int r = 0; r < 16; ++r) { float sq = row16_sum(ss[r]); sq += shx(sq, lane, 16);
            ss[r] = __builtin_amdgcn_rsqf(sq * (1.f / 128.f) + EPS) * obs; }
#pragma unroll
        for (int d0 = 0; d0 < 4; ++d0) { const float gs = subg[d0 * 32 + r32];
#pragma unroll
            for (int r = 0; r < 16; ++r) cbuf[(d0 * 16 + r) * 64] = o[d0][r] * ss[r] * gs; }
    }
    __syncthreads();
    {
        const float* cb0 = (const float*)lds;
#pragma unroll
        for (int jj = 0; jj < 4; ++jj) { const int c = tid + 512 * jj, row = c >> 4, col8 = (c & 15) * 8;
            const int d0 = col8 >> 5, rb = col8 & 31, rgq = row >> 5, within = row & 31, hiq = (within >> 2) & 1, r = (within & 3) + 4 * (within >> 3);
            const float* mp = cb0 + ((rgq * 4 + d0) * 16 + r) * 64 + hiq * 32 + rb;
            const f32x4 m0 = *(const f32x4*)mp, m1 = *(const f32x4*)(mp + 4);
            u32x4 w = {cvtpk(m0[0] * bf2f(gz[jj][0]), m0[1] * bf2f(gz[jj][1])), cvtpk(m0[2] * bf2f(gz[jj][2]), m0[3] * bf2f(gz[jj][3])),
                       cvtpk(m1[0] * bf2f(gz[jj][4]), m1[1] * bf2f(gz[jj][5])), cvtpk(m1[2] * bf2f(gz[jj][6]), m1[3] * bf2f(gz[jj][7]))};
            *(u32x4*)(Yb + (size_t)(qrow0 + row) * DM + YB + h * 128 + col8) = w; }
    }
    __syncthreads();
}

__device__ __forceinline__ void attn_unit_exact(const bf16_t* __restrict__ Pb, bf16_t* __restrict__ Yb, int qrow0, int b, int h, int NT, const float* __restrict__ lamp, const float* __restrict__ subg, char* lds, int wv) {
    const int tid = tid_l(wv), wid = tid >> 6, lane = tid & 63, r32 = lane & 31, hi = lane >> 5, rg = wid & 3, mm = wid >> 2;
    char* V_lds = lds; char* K_lds = lds + 2 * SHM_V;
    float* wsl = (float*)(lds + 8 * SHM_V) + wid * 64; float* li_l = wsl; float* al_l = wsl + 32;
    float m_reg = -1e30f, l_reg = 0; f32x16 o[4] = {}; bf16x8 qr[4];
    const bf16_t* Qw = Pb + (size_t)(qrow0 + rg * 32 + r32) * DIN + COL_Q + h * 128 + mm * 64 + hi * 8;
#pragma unroll
    for (int d0 = 0; d0 < 4; ++d0) qr[d0] = *reinterpret_cast<const bf16x8*>(Qw + d0 * 16);
    const int sr = tid >> 4, sc = (tid & 15) * 8, vst0 = v_st(sr, sc), vst1 = v_st(32 + sr, sc);
    const int vb0 = (int)(uintptr_t)V_lds + v_rd_base(lane);
    const int mcolB = mm * 128;
    const bf16_t* kvc = Pb + (size_t)(NLAT + b * CTXL + sr) * DIN + h * 128 + sc;
    const bf16_t* kvl = Pb + (size_t)(b * SEQ + sr) * DIN + h * 128 + sc - (size_t)256 * DIN;
    struct { bf16x8 vs0, vs1, ks0, ks1; } sr_[1];
#define SLOAD(i, j) do { const bf16_t* _b = ((j) < 4 ? kvc : kvl) + (size_t)(j) * 64 * DIN; \
    sr_[i].vs0 = *reinterpret_cast<const bf16x8*>(_b + COL_V); sr_[i].vs1 = *reinterpret_cast<const bf16x8*>(_b + COL_V + 32 * DIN); \
    sr_[i].ks0 = *reinterpret_cast<const bf16x8*>(_b + COL_K); sr_[i].ks1 = *reinterpret_cast<const bf16x8*>(_b + COL_K + 32 * DIN); } while (0)
#define SWRITE(bb, i) do { *(bf16x8*)(V_lds + (bb) * SHM_V + vst0) = sr_[i].vs0;          \
    *(bf16x8*)(V_lds + (bb) * SHM_V + vst1) = sr_[i].vs1; const int kc = sc * 2;               \
    *(bf16x8*)(K_lds + (bb) * SHM_K + KSWZ(sr, kc)) = sr_[i].ks0;                       \
    *(bf16x8*)(K_lds + (bb) * SHM_K + KSWZ(32 + sr, kc)) = sr_[i].ks1; } while (0)
#define SWAIT() asm volatile("s_waitcnt vmcnt(4)" ::: "memory")
#define RESC(a) do { if (__any((a) < 1.f)) { if (hi == 0) al_l[r32] = (a); asm volatile("s_waitcnt lgkmcnt(0)" ::: "memory"); \
    _Pragma("unroll") for (int d = 0; d < 4; ++d) _Pragma("unroll") for (int r = 0; r < 16; ++r) o[d][r] *= al_l[crow(r, hi)]; } } while (0)
    f32x16 p0, p1; float mn, al; bf16x8 pa0, pa1, pa2, pa3;
    for (int j = 0; j < NT; ++j) {
        SLOAD(0, j); asm volatile("s_waitcnt vmcnt(0)" ::: "memory"); SWRITE(0, 0); __syncthreads();
        qkt(p0, p1, K_lds, qr, r32, hi, mcolB); partialSM(p0, p1, m_reg, mn, al);
        RESC(al);
        finishSM(p0, p1, al, l_reg, pa0, pa1, pa2, pa3); SBAR();
        pv_d0(o, vb0, pa0, pa1, pa2, pa3);
        __syncthreads();
    }
    attn_epilogue(o, l_reg, Pb, Yb, qrow0, h, lamp, subg, lds, li_l, wv);
#undef SLOAD
#undef SWRITE
#undef SWAIT
#undef RESC
}

__device__ __forceinline__ void attn_unit(const bf16_t* __restrict__ Pb, bf16_t* __restrict__ Yb, int qrow0, int b, int h, int NT, const float* __restrict__ lamp, const float* __restrict__ subg, char* lds, PG8_LAS unsigned char* ldsa, int wv) {
    const int tid = tid_l(wv), wid = __builtin_amdgcn_readfirstlane(tid >> 6), lane = tid & 63, r32 = lane & 31, hi = lane >> 5, rg = wid & 3, mm = wid >> 2;
    char* V_lds = lds; char* K_lds = lds + 4 * SHM_V;
    float* li_l = (float*)(lds + 8 * SHM_V) + wid * 64;
    float l_acc = 0.f; f32x16 o[4] = {}; bf16x8 qr[4];
    const bf16_t* Qw = Pb + (size_t)(qrow0 + rg * 32 + r32) * DIN + COL_Q + h * 128 + mm * 64 + hi * 8;
#pragma unroll
    for (int d0 = 0; d0 < 4; ++d0) qr[d0] = *reinterpret_cast<const bf16x8*>(Qw + d0 * 16);
    const int vb0 = (int)(uintptr_t)V_lds + v_rd_base(lane);
    const int mcolB = mm * 128;
    unsigned koff[2], voff[2];
#pragma unroll
    for (int i = 0; i < 2; ++i) { const int ci = wid * 128 + i * 64 + lane;
        { const int row = ci >> 4, cc = (ci & 15) ^ (row & 15); koff[i] = (unsigned)(row * DIN + COL_K + h * 128 + cc * 8) * 2u; }
        { const int sub = ci >> 5, k = (sub >> 2) * 8 + ((ci & 31) >> 2), c = (sub & 3) * 32 + (ci & 3) * 8; voff[i] = (unsigned)(k * DIN + COL_V + h * 128 + c) * 2u; } }
    const bf16_t* kvc = Pb + (size_t)(NLAT + b * CTXL) * DIN;
    const bf16_t* kvl = Pb + (size_t)(b * SEQ) * DIN - (size_t)256 * DIN;
#define KVBASE(t) ((const char*)(((t) < 4 ? kvc : kvl) + (size_t)(t) * 64 * DIN))
#define DMAV2(t, tb) do { const char* _b = KVBASE(t); const int _bo = ((tb) & 3) * SHM_V + wid * 2048; \
    _Pragma("unroll") for (int _i = 0; _i < 2; ++_i) __builtin_amdgcn_global_load_lds((const unsigned*)(_b + voff[_i]), (PG8_LAS unsigned*)(ldsa + _bo + _i * 1024), 16, 0, 0); } while (0)
#define DMAK2(t, tb) do { const char* _b = KVBASE(t); const int _bo = ((tb) & 3) * SHM_V + wid * 2048; \
    _Pragma("unroll") for (int _i = 0; _i < 2; ++_i) __builtin_amdgcn_global_load_lds((const unsigned*)(_b + koff[_i]), (PG8_LAS unsigned*)(ldsa + 4 * SHM_V + _bo + _i * 1024), 16, 0, 0); } while (0)
#define BOFF(t) (((t) & 3) * SHM_V)
#define QKTF(P0, P1, Ks) do { _Pragma("unroll") for (int d0 = 0; d0 < 4; ++d0) { const int cb = mcolB + (d0 * 16 + hi * 8) * 2; \
        const bf16x8 kb0 = *reinterpret_cast<const bf16x8*>((Ks) + KSWZ(r32, cb)); const bf16x8 kb1 = *reinterpret_cast<const bf16x8*>((Ks) + KSWZ(32 + r32, cb)); \
        P0 = __builtin_amdgcn_mfma_f32_32x32x16_bf16(kb0, qr[d0], d0 == 0 ? NI : P0, 0, 0, 0); P1 = __builtin_amdgcn_mfma_f32_32x32x16_bf16(kb1, qr[d0], d0 == 0 ? NI : P1, 0, 0, 0); \
        if (d0 == 1) SBAR(); } } while (0)
#define EXPH(P) do { _Pragma("unroll") for (int r = 0; r < 16; ++r) P[r] = __builtin_amdgcn_exp2f(P[r]); } while (0)
#define PK4(P, BASE, OUT) do { unsigned a0 = cvtpk(P[BASE + 0], P[BASE + 1]), a1 = cvtpk(P[BASE + 2], P[BASE + 3]);   \
    unsigned b0 = cvtpk(P[BASE + 4], P[BASE + 5]), b1 = cvtpk(P[BASE + 6], P[BASE + 7]);                              \
    auto r0 = __builtin_amdgcn_permlane32_swap(a0, b0, false, false); auto r1 = __builtin_amdgcn_permlane32_swap(a1, b1, false, false); \
    u32x4 w = {r0[0], r1[0], r0[1], r1[1]}; OUT = *reinterpret_cast<bf16x8*>(&w); } while (0)
#define FINF(P0, P1) do { EXPH(P1); float s0 = P0[0] + P1[0], s1 = P0[1] + P1[1], s2 = P0[2] + P1[2], s3 = P0[3] + P1[3]; \
    _Pragma("unroll") for (int r = 4; r < 16; r += 4) { s0 += P0[r] + P1[r]; s1 += P0[r + 1] + P1[r + 1]; s2 += P0[r + 2] + P1[r + 2]; s3 += P0[r + 3] + P1[r + 3]; } \
    l_acc += (s0 + s1) + (s2 + s3); PK4(P0, 0, pa0); PK4(P0, 8, pa1); PK4(P1, 0, pa2); PK4(P1, 8, pa3); } while (0)
    f32x16 pA0, pA1, pB0, pB1, NI; bf16x8 pa0, pa1, pa2, pa3;
    const int kbase = (int)(uintptr_t)K_lds;
    const int kad0 = kbase + KSWZ(r32, mcolB + (0 * 16 + hi * 8) * 2), kad1 = kbase + KSWZ(r32, mcolB + (1 * 16 + hi * 8) * 2),
              kad2 = kbase + KSWZ(r32, mcolB + (2 * 16 + hi * 8) * 2), kad3 = kbase + KSWZ(r32, mcolB + (3 * 16 + hi * 8) * 2);
#define RBAR() do { asm volatile("" ::: "memory"); __builtin_amdgcn_s_barrier(); asm volatile("" ::: "memory"); } while (0)
    DMAK2(0, 0); DMAK2(1, 1); DMAK2(2, 2); DMAV2(0, 0); DMAV2(1, 1);
    asm volatile("s_waitcnt vmcnt(0)" ::: "memory"); RBAR();
    {
        qkt(pA0, pA1, K_lds, qr, r32, hi, mcolB);
        float pmax = pA0[0];
#pragma unroll
        for (int r = 1; r < 16; ++r) pmax = fmaxf(pmax, pA0[r]);
#pragma unroll
        for (int r = 0; r < 16; ++r) pmax = fmaxf(pmax, pA1[r]);
        { auto rr = __builtin_amdgcn_permlane32_swap(__float_as_uint(pmax), __float_as_uint(pmax), false, false); pmax = fmaxf(__uint_as_float(rr[0]), __uint_as_float(rr[1])); }
#pragma unroll
        for (int r = 0; r < 16; ++r) NI[r] = -pmax;
    }
    QKTF(pA0, pA1, K_lds); EXPH(pA0);
#define EXP4(P, B) do { P[B] = __builtin_amdgcn_exp2f(P[B]); P[B + 1] = __builtin_amdgcn_exp2f(P[B + 1]); P[B + 2] = __builtin_amdgcn_exp2f(P[B + 2]); P[B + 3] = __builtin_amdgcn_exp2f(P[B + 3]); } while (0)
#define KFR(d0, half) (*reinterpret_cast<const bf16x8*>(_ks + KSWZ((half) * 32 + r32, mcolB + ((d0) * 16 + hi * 8) * 2)))
#define LOADG(F, KS, VB) do { F##0l = tr_read<v_rd_off(0, KS, 0)>(VB); F##0h = tr_read<v_rd_off(0, KS, 1)>(VB); F##1l = tr_read<v_rd_off(1, KS, 0)>(VB); F##1h = tr_read<v_rd_off(1, KS, 1)>(VB); \
    F##2l = tr_read<v_rd_off(2, KS, 0)>(VB); F##2h = tr_read<v_rd_off(2, KS, 1)>(VB); F##3l = tr_read<v_rd_off(3, KS, 0)>(VB); F##3h = tr_read<v_rd_off(3, KS, 1)>(VB); } while (0)
#define PIN(x) asm volatile("" : "+v"(x))
#define EXP2E(P, i) do { P[i] = __builtin_amdgcn_exp2f(P[i]); P[(i) + 1] = __builtin_amdgcn_exp2f(P[(i) + 1]); } while (0)
#define SWP(r, a, b) do { auto _r = __builtin_amdgcn_permlane32_swap(a, b, false, false); r##x = _r[0]; r##y = _r[1]; PIN(r##x); PIN(r##y); } while (0)
#define MKPA(OUT, r0, r1) do { u32x4 _w = {r0##x, r1##x, r0##y, r1##y}; OUT = *reinterpret_cast<bf16x8*>(&_w); PIN(OUT); } while (0)
#define QKM(N, kf, d0, C) do { PIN(kf); N = __builtin_amdgcn_mfma_f32_32x32x16_bf16(kf, qr[d0], C, 0, 0, 0); PIN(N); } while (0)
#define PKN(OUT, P, B) do { u32x4 _w = {cvtpk(P[B], P[B + 1]), cvtpk(P[B + 2], P[B + 3]), cvtpk(P[B + 4], P[B + 5]), cvtpk(P[B + 6], P[B + 7])}; OUT = *reinterpret_cast<bf16x8*>(&_w); PIN(OUT); } while (0)
#define PKH(W, P, B) do { W = cvtpk(P[B], P[B + 1]); } while (0)
#define KRD(dst, addr, OFF) asm volatile("ds_read_b128 %0, %1 offset:" #OFF : "=&v"(dst) : "v"(addr) : "memory")
#define WAITK(n, ka, kb) asm volatile("s_waitcnt lgkmcnt(" #n ")" : "+v"(ka), "+v"(kb) :: "memory")
#define H1STEP(P0, P1, N0, N1, KOFF, VBN) do { const int _ko = (KOFF); unsigned _w0, _w1, _w2, _w3; bf16x8 k00, k01, k10, k11, k20, k21, k30, k31; \
    { const int _a0 = kad0 + _ko, _a1 = kad1 + _ko, _a2 = kad2 + _ko, _a3 = kad3 + _ko; \
      KRD(k00, _a0, 0); KRD(k01, _a0, 8192); KRD(k10, _a1, 0); KRD(k11, _a1, 8192); KRD(k20, _a2, 0); KRD(k21, _a2, 8192); KRD(k30, _a3, 0); KRD(k31, _a3, 8192); } \
    PIN(P1); PIN(P0); \
    WAITK(6, k00, k01); \
    QKM(N0, k00, 0, NI); EXP2E(P1, 0);  PIN(P1); PKH(_w0, P0, 0); \
    QKM(N1, k01, 0, NI); EXP2E(P1, 2);  PIN(P1); PKH(_w1, P0, 2); \
    WAITK(4, k10, k11); \
    QKM(N0, k10, 1, N0); EXP2E(P1, 4);  PIN(P1); PKH(_w2, P0, 4); \
    QKM(N1, k11, 1, N1); EXP2E(P1, 6);  PIN(P1); PKH(_w3, P0, 6); { u32x4 _w = {_w0, _w1, _w2, _w3}; pa0 = *reinterpret_cast<bf16x8*>(&_w); PIN(pa0); } \
    WAITK(2, k20, k21); \
    QKM(N0, k20, 2, N0); EXP2E(P1, 8);  PIN(P1); PKH(_w0, P0, 8); \
    QKM(N1, k21, 2, N1); EXP2E(P1, 10); PIN(P1); PKH(_w1, P0, 10); \
    WAITK(0, k30, k31); \
    QKM(N0, k30, 3, N0); EXP2E(P1, 12); PIN(P1); PKH(_w2, P0, 12); \
    QKM(N1, k31, 3, N1); EXP2E(P1, 14); PIN(P1); PKH(_w3, P0, 14); { u32x4 _w = {_w0, _w1, _w2, _w3}; pa1 = *reinterpret_cast<bf16x8*>(&_w); PIN(pa1); } \
    LOADG(fa, 0, VBN); LOADG(fb, 1, VBN); } while (0)
#define PKV(L, H) (bf16x8){L[0], L[1], L[2], L[3], H[0], H[1], H[2], H[3]}
#define PVM(i, PA, FL, FH) do { o[i] = __builtin_amdgcn_mfma_f32_32x32x16_bf16(PA, PKV(FL, FH), o[i], 0, 0, 0); PIN(o[i]); } while (0)
#define SUM2(g, A0, A1) do { _s0 += A0[2 * (g)] + A1[2 * (g)]; _s1 += A0[2 * (g) + 1] + A1[2 * (g) + 1]; PIN(_s0); PIN(_s1); } while (0)
#define WAITL(n, F) asm volatile("s_waitcnt lgkmcnt(" #n ")" : "+v"(F##0l), "+v"(F##0h), "+v"(F##1l), "+v"(F##1h), "+v"(F##2l), "+v"(F##2h), "+v"(F##3l), "+v"(F##3h) :: "memory")
#define H2STEP(VB, P0, P1, N0) do { const int _vb = (VB); unsigned _w0, _w1, _w2, _w3; float _s0 = 0.f, _s1 = 0.f; \
    PIN(N0); PIN(P1); \
    WAITL(8, fa); \
    PVM(0, pa0, fa0l, fa0h); SUM2(0, P0, P1); PKH(_w0, P1, 0); \
    PVM(1, pa0, fa1l, fa1h); SUM2(1, P0, P1); PKH(_w1, P1, 2); \
    PVM(2, pa0, fa2l, fa2h); SUM2(2, P0, P1); PKH(_w2, P1, 4); \
    PVM(3, pa0, fa3l, fa3h); SUM2(3, P0, P1); PKH(_w3, P1, 6); { u32x4 _w = {_w0, _w1, _w2, _w3}; pa2 = *reinterpret_cast<bf16x8*>(&_w); PIN(pa2); } \
    LOADG(fa, 2, _vb); WAITL(8, fb); \
    PVM(0, pa1, fb0l, fb0h); SUM2(4, P0, P1); PKH(_w0, P1, 8); \
    PVM(1, pa1, fb1l, fb1h); SUM2(5, P0, P1); PKH(_w1, P1, 10); \
    PVM(2, pa1, fb2l, fb2h); SUM2(6, P0, P1); PKH(_w2, P1, 12); \
    PVM(3, pa1, fb3l, fb3h); SUM2(7, P0, P1); PKH(_w3, P1, 14); { u32x4 _w = {_w0, _w1, _w2, _w3}; pa3 = *reinterpret_cast<bf16x8*>(&_w); PIN(pa3); } l_acc += _s0 + _s1; PIN(l_acc); \
    LOADG(fb, 3, _vb); WAITL(8, fa); \
    PVM(0, pa2, fa0l, fa0h); EXP2E(N0, 0);  PIN(N0); \
    PVM(1, pa2, fa1l, fa1h); EXP2E(N0, 2);  PIN(N0); \
    PVM(2, pa2, fa2l, fa2h); EXP2E(N0, 4);  PIN(N0); \
    PVM(3, pa2, fa3l, fa3h); EXP2E(N0, 6);  PIN(N0); \
    WAITL(0, fb); \
    PVM(0, pa3, fb0l, fb0h); EXP2E(N0, 8);  PIN(N0); \
    PVM(1, pa3, fb1l, fb1h); EXP2E(N0, 10); PIN(N0); \
    PVM(2, pa3, fb2l, fb2h); EXP2E(N0, 12); PIN(N0); \
    PVM(3, pa3, fb3l, fb3h); EXP2E(N0, 14); PIN(N0); } while (0)
#define H1LAST(P0, P1, VBN) do { unsigned _w0, _w1, _w2, _w3; \
    PIN(P1); PIN(P0); \
    EXP2E(P1, 0);  PIN(P1); PKH(_w0, P0, 0); \
    EXP2E(P1, 2);  PIN(P1); PKH(_w1, P0, 2); \
    EXP2E(P1, 4);  PIN(P1); PKH(_w2, P0, 4); \
    EXP2E(P1, 6);  PIN(P1); PKH(_w3, P0, 6); { u32x4 _w = {_w0, _w1, _w2, _w3}; pa0 = *reinterpret_cast<bf16x8*>(&_w); PIN(pa0); } \
    EXP2E(P1, 8);  PIN(P1); PKH(_w0, P0, 8); \
    EXP2E(P1, 10); PIN(P1); PKH(_w1, P0, 10); \
    EXP2E(P1, 12); PIN(P1); PKH(_w2, P0, 12); \
    EXP2E(P1, 14); PIN(P1); PKH(_w3, P0, 14); { u32x4 _w = {_w0, _w1, _w2, _w3}; pa1 = *reinterpret_cast<bf16x8*>(&_w); PIN(pa1); } \
    LOADG(fa, 0, VBN); LOADG(fb, 1, VBN); } while (0)
#define H2LAST(VB, P0, P1) do { const int _vb = (VB); unsigned _w0, _w1, _w2, _w3; float _s0 = 0.f, _s1 = 0.f; \
    PIN(P1); \
    WAITL(8, fa); \
    PVM(0, pa0, fa0l, fa0h); SUM2(0, P0, P1); PKH(_w0, P1, 0); \
    PVM(1, pa0, fa1l, fa1h); SUM2(1, P0, P1); PKH(_w1, P1, 2); \
    PVM(2, pa0, fa2l, fa2h); SUM2(2, P0, P1); PKH(_w2, P1, 4); \
    PVM(3, pa0, fa3l, fa3h); SUM2(3, P0, P1); PKH(_w3, P1, 6); { u32x4 _w = {_w0, _w1, _w2, _w3}; pa2 = *reinterpret_cast<bf16x8*>(&_w); PIN(pa2); } \
    LOADG(fa, 2, _vb); WAITL(8, fb); \
    PVM(0, pa1, fb0l, fb0h); SUM2(4, P0, P1); PKH(_w0, P1, 8); \
    PVM(1, pa1, fb1l, fb1h); SUM2(5, P0, P1); PKH(_w1, P1, 10); \
    PVM(2, pa1, fb2l, fb2h); SUM2(6, P0, P1); PKH(_w2, P1, 12); \
    PVM(3, pa1, fb3l, fb3h); SUM2(7, P0, P1); PKH(_w3, P1, 14); { u32x4 _w = {_w0, _w1, _w2, _w3}; pa3 = *reinterpret_cast<bf16x8*>(&_w); PIN(pa3); } l_acc += _s0 + _s1; PIN(l_acc); \
    LOADG(fb, 3, _vb); WAITL(8, fa); \
    PVM(0, pa2, fa0l, fa0h); \
    PVM(1, pa2, fa1l, fa1h); \
    PVM(2, pa2, fa2l, fa2h); \
    PVM(3, pa2, fa3l, fa3h); \
    WAITL(0, fb); \
    PVM(0, pa3, fb0l, fb0h); \
    PVM(1, pa3, fb1l, fb1h); \
    PVM(2, pa3, fb2l, fb2h); \
    PVM(3, pa3, fb3l, fb3h); } while (0)
    if (mm == 1) __builtin_amdgcn_s_setprio(1);
    RBAR();
#define CLAMPT(x) ((x) < NT ? (x) : NT - 1)
    for (int t = 0; t + 2 < NT; t += 2) {
        const int b0 = BOFF(t), b1 = BOFF(t + 1), b2 = BOFF(t + 2);
        s16x4 fa0l, fa0h, fa1l, fa1h, fa2l, fa2h, fa3l, fa3h, fb0l, fb0h, fb1l, fb1h, fb2l, fb2h, fb3l, fb3h;
        DMAK2(CLAMPT(t + 3), t + 3); DMAV2(CLAMPT(t + 2), t + 2); DMAK2(CLAMPT(t + 4), t + 4); DMAV2(CLAMPT(t + 3), t + 3);
        H1STEP(pA0, pA1, pB0, pB1, b1, vb0 + b0);
        H2STEP(vb0 + b0, pA0, pA1, pB0);
        H1STEP(pB0, pB1, pA0, pA1, b2, vb0 + b1);
        H2STEP(vb0 + b1, pB0, pB1, pA0);
        asm volatile("s_waitcnt vmcnt(0)" ::: "memory");
        RBAR();
    }
#undef CLAMPT
    {
        const int b0 = BOFF(NT - 2), b1 = BOFF(NT - 1);
        s16x4 fa0l, fa0h, fa1l, fa1h, fa2l, fa2h, fa3l, fa3h, fb0l, fb0h, fb1l, fb1h, fb2l, fb2h, fb3l, fb3h;
        H1STEP(pA0, pA1, pB0, pB1, b1, vb0 + b0);
        H2STEP(vb0 + b0, pA0, pA1, pB0);
        H1LAST(pB0, pB1, vb0 + b1);
        H2LAST(vb0 + b1, pB0, pB1);
    }
    asm volatile("s_waitcnt vmcnt(0)" ::: "memory");
    __builtin_amdgcn_s_setprio(0);
#undef PIN
#undef EXP4
#undef KFR
#undef H1STEP
#undef H1LAST
#undef H2LAST
#undef KRD
#undef WAITK
#undef PKN
#undef PKH
#undef EXP2E
#undef SWP
#undef MKPA
#undef QKM
#undef PVM
#undef SUM2
#undef LOADG
#undef PKV
#undef WAITL
#undef H2STEP
    float l_full; { auto rr = __builtin_amdgcn_permlane32_swap(__float_as_uint(l_acc), __float_as_uint(l_acc), false, false); l_full = __uint_as_float(rr[0]) + __uint_as_float(rr[1]); }
    const int bad = !(l_full < 1e30f);
    float* flg = (float*)(lds + 8 * SHM_V) + 512;
    if ((tid_l(wv) & 63) == 0) flg[wid] = __any(bad) ? 1.f : 0.f;
    __syncthreads();
    if (((flg[0] + flg[1]) + (flg[2] + flg[3])) + ((flg[4] + flg[5]) + (flg[6] + flg[7])) > 0.f) { __syncthreads(); attn_unit_exact(Pb, Yb, qrow0, b, h, NT, lamp, subg, lds, wv); return; }
    attn_epilogue(o, l_full, Pb, Yb, qrow0, h, lamp, subg, lds, li_l, wv);
#undef RBAR
#undef KVBASE
#undef DMAV2
#undef DMAK2
#undef BOFF
#undef QKTF
#undef EXPH
#undef PK4
#undef FINF
}
}

__device__ __forceinline__ void light_unit(CParams& p, int l, int ch, int part, char* lds, int wv) {
    const int tid = tid_l(wv), wid = tid >> 6, lane = tid & 63, r32 = lane & 31, hi = lane >> 5;
    const int row0 = ch * 128;
    const bf16_t* Pb = p.P; bf16_t* Yb = p.HY;
    const int rg = wid & 3, hh = wid >> 2, head = part * 2 + hh;
    const int sr_ = tid >> 2, sj = tid & 3;
    bf16x8 v[8];
    { const bf16_t* src = Pb + (size_t)(row0 + sr_) * DIN + COL_AV + sj * 64;
#pragma unroll
      for (int i = 0; i < 8; ++i) v[i] = *reinterpret_cast<const bf16x8*>(src + i * 8); }
    f32x4 gg[16];
    { const float* g = p.sgu_g + l * 256 + sj * 64;
#pragma unroll
      for (int i = 0; i < 16; ++i) gg[i] = *(const f32x4*)(g + i * 4); }
    const int cgp = tid & 15, rr = tid >> 4, cc = part * 128 + cgp * 8;
    const int s0 = row0 < NLAT ? (row0 & ~(SEQ - 1)) : NLAT + ((row0 - NLAT) & ~(CTXL - 1)), s1 = s0 + (row0 < NLAT ? SEQ : CTXL);
    bf16x8 cv[2][4];
#define CONV_LOAD(slot, i) do { const int t = row0 + rr + 32 * (i); const bf16_t* base = Pb + (size_t)t * DIN + cc; \
        cv[slot][0] = *reinterpret_cast<const bf16x8*>(base + COL_CC); cv[slot][1] = *reinterpret_cast<const bf16x8*>(base + COL_CB); \
        cv[slot][2] = (bf16x8){}; cv[slot][3] = (bf16x8){}; \
        if (t - 1 >= s0) cv[slot][2] = *reinterpret_cast<const bf16x8*>(base - DIN + COL_CC); \
        if (t + 1 < s1)  cv[slot][3] = *reinterpret_cast<const bf16x8*>(base + DIN + COL_CC); } while (0)
#define CONV_DO(slot, i) do { const int t = row0 + rr + 32 * (i); float y[8];        \
        _Pragma("unroll") for (int e = 0; e < 8; ++e) y[e] = bf2f(cv[slot][1][e]) * (w0[e] * bf2f(cv[slot][2][e]) + w1[e] * bf2f(cv[slot][0][e]) + w2[e] * bf2f(cv[slot][3][e]) + bb[e]); \
        u32x4 w = {cvtpk(y[0], y[1]), cvtpk(y[2], y[3]), cvtpk(y[4], y[5]), cvtpk(y[6], y[7])}; *(u32x4*)(Yb + (size_t)t * DM + YC + cc) = w; } while (0)
    CONV_LOAD(0, 0);
    float w0[8], w1[8], w2[8], bb[8];
    { const float* cw = p.conv_w + (size_t)l * 3 * 256 + cc; const float* cbv = p.conv_b + l * 256 + cc;
#pragma unroll
      for (int e = 0; e < 8; ++e) { w0[e] = cw[e]; w1[e] = cw[256 + e]; w2[e] = cw[512 + e]; bb[e] = cbv[e]; } }
    {   float ss = 0.f;
#pragma unroll
        for (int i = 0; i < 8; ++i)
#pragma unroll
            for (int e = 0; e < 8; ++e) { const float f = bf2f(v[i][e]); ss += f * f; }
        ss += shx(ss, lane, 1); ss += shx(ss, lane, 2);
        const float rstd = __builtin_amdgcn_rsqf(ss * (1.f / 256.f) + EPS);
        if ((sj >> 1) == part) {
            const int cbase = (sj & 1) * 64;
#pragma unroll
            for (int i = 0; i < 8; ++i) { const f32x4 g0 = gg[2 * i], g1 = gg[2 * i + 1];
                u32x4 w; w.x = cvtpk(bf2f(v[i][0]) * rstd * g0[0], bf2f(v[i][1]) * rstd * g0[1]); w.y = cvtpk(bf2f(v[i][2]) * rstd * g0[2], bf2f(v[i][3]) * rstd * g0[3]);
                w.z = cvtpk(bf2f(v[i][4]) * rstd * g1[0], bf2f(v[i][5]) * rstd * g1[1]); w.w = cvtpk(bf2f(v[i][6]) * rstd * g1[2], bf2f(v[i][7]) * rstd * g1[3]);
                *(u32x4*)(lds + (sr_ >> 6) * at::SHM_V + at::v_st(sr_ & 63, cbase + i * 8)) = w; }
        }
    }
    f32x4 wa[2][4], wb[2][4];
    { const float* W = p.sgu_w + ((size_t)(l * 4 + head) * 128 + rg * 32 + r32) * 128 + hi * 8;
#pragma unroll
      for (int tile = 0; tile < 2; ++tile)
#pragma unroll
          for (int ks = 0; ks < 4; ++ks) { wa[tile][ks] = *(const f32x4*)(W + tile * 64 + ks * 16); wb[tile][ks] = *(const f32x4*)(W + tile * 64 + ks * 16 + 4); } }
    bf16x8 gu[4];
#pragma unroll
    for (int jj = 0; jj < 4; ++jj) { const int c = tid + 512 * jj, row = c >> 4, col8 = (c & 15) * 8;
        gu[jj] = *reinterpret_cast<const bf16x8*>(Pb + (size_t)(row0 + row) * DIN + COL_AU + part * 128 + col8); }
    __syncthreads();
    CONV_DO(0, 0); CONV_LOAD(1, 1);
    {
        f32x16 o0 = {}, o1 = {};
        const int vb0 = (int)(uintptr_t)lds + at::v_rd_base(lane);
#pragma unroll
        for (int tile = 0; tile < 2; ++tile) {
            bf16x8 pa[4];
#pragma unroll
            for (int ks = 0; ks < 4; ++ks) { const f32x4 a = wa[tile][ks], bq = wb[tile][ks];
                u32x4 w = {cvtpk(a[0], a[1]), cvtpk(a[2], a[3]), cvtpk(bq[0], bq[1]), cvtpk(bq[2], bq[3])}; pa[ks] = *reinterpret_cast<bf16x8*>(&w); }
            if (hh == 0) { at::pv_one<0>(o0, vb0 + tile * at::SHM_V, pa[0], pa[1], pa[2], pa[3]); at::pv_one<1>(o1, vb0 + tile * at::SHM_V, pa[0], pa[1], pa[2], pa[3]); }
            else         { at::pv_one<2>(o0, vb0 + tile * at::SHM_V, pa[0], pa[1], pa[2], pa[3]); at::pv_one<3>(o1, vb0 + tile * at::SHM_V, pa[0], pa[1], pa[2], pa[3]); }
        }
        const float* bs = p.sgu_b + (size_t)(l * 4 + head) * 128 + rg * 32;
        float* mx = (float*)(lds + 2 * at::SHM_V) + ((hh * 4 + rg) * 2) * 1024 + lane;
#pragma unroll
        for (int q = 0; q < 4; ++q) { const f32x4 b4 = *(const f32x4*)(bs + 8 * q + 4 * hi);
#pragma unroll
            for (int j = 0; j < 4; ++j) { const int r = 4 * q + j; mx[r * 64] = o0[r] + b4[j]; mx[1024 + r * 64] = o1[r] + b4[j]; } }
    }
    __syncthreads();
    CONV_DO(1, 1); CONV_LOAD(0, 2);
    {
        const float* mbase = (const float*)(lds + 2 * at::SHM_V);
#pragma unroll
        for (int jj = 0; jj < 4; ++jj) { const int c = tid + 512 * jj, row = c >> 4, col8 = (c & 15) * 8;
            const int hq = col8 >> 6, d = col8 & 63, dd = d >> 5, rb = d & 31, rgq = row >> 5, within = row & 31, hiq = (within >> 2) & 1, r = (within & 3) + 4 * (within >> 3);
            const float* mp = mbase + (((hq * 4 + rgq) * 2 + dd) * 16 + r) * 64 + hiq * 32 + rb;
            const f32x4 m0 = *(const f32x4*)mp, m1 = *(const f32x4*)(mp + 4);
            u32x4 w = {cvtpk(m0[0] * bf2f(gu[jj][0]), m0[1] * bf2f(gu[jj][1])), cvtpk(m0[2] * bf2f(gu[jj][2]), m0[3] * bf2f(gu[jj][3])),
                       cvtpk(m1[0] * bf2f(gu[jj][4]), m1[1] * bf2f(gu[jj][5])), cvtpk(m1[2] * bf2f(gu[jj][6]), m1[3] * bf2f(gu[jj][7]))};
            *(u32x4*)(Yb + (size_t)(row0 + row) * DM + YA + part * 128 + col8) = w; }
    }
    CONV_DO(0, 2); CONV_LOAD(1, 3);
    CONV_DO(1, 3);
#undef CONV_LOAD
#undef CONV_DO
    __syncthreads();
}

__device__ __forceinline__ void sincos_f(float a, float& s, float& c) {
    const float k = rintf(a * 0.636619772f);
    float r = fmaf(-k, 1.5707962513e+00f, a); r = fmaf(-k, 7.5497894159e-08f, r); r = fmaf(-k, 5.3903029534e-15f, r);
    const float r2 = r * r;
    float sp = 2.7557319224e-6f; sp = fmaf(sp, r2, -1.9841269841e-4f); sp = fmaf(sp, r2, 8.3333333333e-3f); sp = fmaf(sp, r2, -1.6666666667e-1f); const float sr = fmaf(r * r2, sp, r);
    float cp = 2.4801587302e-5f; cp = fmaf(cp, r2, -1.3888888889e-3f); cp = fmaf(cp, r2, 4.1666666667e-2f); cp = fmaf(cp, r2, -0.5f); const float cr = fmaf(r2, cp, 1.0f);
    const int q = ((int)k) & 3;
    s = (q == 0) ? sr : (q == 1) ? cr : (q == 2) ? -sr : -cr;
    c = (q == 0) ? cr : (q == 1) ? -sr : (q == 2) ? -cr : sr;
}

__device__ __forceinline__ void convert_weights(CParams& p, int l, int first, int stride, char* lds, int wv) {
    const int tid = tid_l(wv);
    float* T = (float*)lds;
    const float* srcI = p.w_in + (size_t)l * DM * DIN; bf16_t* dstI = p.WinT + (size_t)l * DIN * DM;
    const float* srcO = p.w_out + (size_t)l * DM * DM; bf16_t* dstO = p.WoutT + (size_t)l * DM * DM;
    for (int u0 = first; u0 < 1216; u0 += 4 * stride) {
        f32x4 va[4], vb[4]; bf16_t* dq[4];
#pragma unroll
        for (int q = 0; q < 4; ++q) { const int u = u0 + q * stride; va[q] = (f32x4){0.f, 0.f, 0.f, 0.f}; vb[q] = va[q]; dq[q] = nullptr;
            if (u < 1216) { const float* src; bf16_t* dst; int N, kt, nt;
                int ntd;
                if (u < 960) { kt = u / 60; nt = u % 60; src = srcI; dst = dstI; N = DIN;
                    const int blk = nt >> 1, nb = blk == 1 ? 4 : blk == 4 ? 1 : blk == 23 ? 28 : blk == 28 ? 23 : blk == 25 ? 26 : blk == 26 ? 25 : blk; ntd = nb * 2 + (nt & 1); }
                else { const int v = u - 960; kt = v / 16; nt = v % 16; src = srcO; dst = dstO; N = DM; ntd = nt; }
                const int row = tid >> 3, cs = (tid & 7) * 8; const float* sp = src + (size_t)(kt * 64 + row) * N + nt * 64 + cs;
                va[q] = __builtin_nontemporal_load((const f32x4*)sp); vb[q] = __builtin_nontemporal_load((const f32x4*)(sp + 4));
                dq[q] = dst + (size_t)(ntd * 64 + (tid >> 3)) * DM + kt * 64 + (tid & 7) * 8; } }
#pragma unroll
        for (int q = 0; q < 4; ++q) { const int row = tid >> 3, cs = (tid & 7) * 8; float* t = T + q * 4160 + row * 65 + cs;
            t[0] = va[q][0]; t[1] = va[q][1]; t[2] = va[q][2]; t[3] = va[q][3]; t[4] = vb[q][0]; t[5] = vb[q][1]; t[6] = vb[q][2]; t[7] = vb[q][3]; }
        __syncthreads();
#pragma unroll
        for (int q = 0; q < 4; ++q) { const int n = tid >> 3, kc = (tid & 7) * 8; const float* t = T + q * 4160 + kc * 65 + n;
            if (dq[q]) { u32x4 w = {cvtpk(t[0], t[65]), cvtpk(t[130], t[195]), cvtpk(t[260], t[325]), cvtpk(t[390], t[455])}; *(u32x4*)dq[q] = w; } }
        __syncthreads();
    }
}

__device__ __forceinline__ void phase_prep(CParams& p, char* lds, int wv) {
    const int tid = tid_l(wv), bid = bid_l();
    float* S = (float*)(lds + 4 * 16640);
    float* R = (float*)(lds + 4 * 16640 + 12288);
    convert_weights(p, 0, bid, (int)gridDim.x, lds, wv);
    if (bid < 192) {
        for (int i = tid; i < 3072; i += 512) { const int cnd = i >> 10, k = i & 1023; const float v = cnd < 2 ? p.c[cnd * 1024 + k] : p.c_ctx[k]; S[i] = v / (1.f + expf(-v)); }
        __syncthreads();
        for (int u = bid; u < 192; u += gridDim.x) {
            const int l = u / 48, c0 = (u % 48) * 64, j4 = (tid & 15) * 4, kg = tid >> 4;
            const float* w = p.w_mod + (size_t)l * DM * 3072 + c0 + j4;
            f32x4 a0 = {0.f, 0.f, 0.f, 0.f}, a1 = a0, a2 = a0;
#pragma unroll 8
            for (int k = kg; k < 1024; k += 32) { const f32x4 wv4 = __builtin_nontemporal_load((const f32x4*)(w + (size_t)k * 3072)); a0 += wv4 * S[k]; a1 += wv4 * S[1024 + k]; a2 += wv4 * S[2048 + k]; }
            *(f32x4*)(R + (0 * 32 + kg) * 64 + j4) = a0; *(f32x4*)(R + (1 * 32 + kg) * 64 + j4) = a1; *(f32x4*)(R + (2 * 32 + kg) * 64 + j4) = a2;
            __syncthreads();
            if (tid < 192) { const int cnd = tid >> 6, jj = tid & 63; float sm = 0.f;
#pragma unroll
                for (int g = 0; g < 32; ++g) sm += R[(cnd * 32 + g) * 64 + jj];
                p.mod[(size_t)(l * 3 + cnd) * 3072 + c0 + jj] = sm + p.b_mod[l * 3072 + c0 + jj]; }
            __syncthreads();
        }
    }
    if (bid == (int)gridDim.x - 1) {
        for (int i = tid; i < 2048; i += 512) { const int pos = i >> 4, pp = i & 15;
            const float inv = __builtin_amdgcn_exp2f(-(float)pp * 0.830482023721841f);
            float s, c; sincos_f((float)pos * inv, s, c); p.rope[i] = c; p.rope[2048 + i] = s; }
        if (tid < DEPTH) { float d1 = 0.f, d2 = 0.f;
            for (int k = 0; k < 64; ++k) { d1 += p.lq1[tid * 64 + k] * p.lk1[tid * 64 + k]; d2 += p.lq2[tid * 64 + k] * p.lk2[tid * 64 + k]; }
            const float li = 0.8f - 0.6f * expf(-0.3f * (float)tid); p.lam[tid] = expf(d1) - expf(d2) + li; p.lam[DEPTH + tid] = 1.f - li; }
    }
}

__device__ __forceinline__ float wave_sum(float v, int lane) {
    v = row16_sum(v); v += shx(v, lane, 16); v += shx(v, lane, 32); return v;
}
__device__ __forceinline__ void phase_norm(CParams& p, int l, int wv) {
    const int tid = tid_l(wv), wid = tid >> 6, lane = tid & 63, bid = bid_l();
    const float* modl = p.mod + (size_t)l * 3 * 3072; const float* g = p.norm_g + l * DM;
    f32x4 ga[4], sb[4]; int cur = -1;
    const int stride = (int)gridDim.x * 8;
    f32x4 v[4], vn[4];
#define XROW(r) ((l == 0) ? ((r) < NLAT ? p.x + (size_t)(r) * DM : p.ctx + (size_t)((r) - NLAT) * DM) : ((r) < NLAT ? p.xlat + (size_t)(r) * DM : p.xctx + (size_t)((r) - NLAT) * DM))
    int row = bid * 8 + wid;
    if (row < NROW) { const float* xr = XROW(row);
#pragma unroll
        for (int i = 0; i < 4; ++i) v[i] = *(const f32x4*)(xr + i * 256 + lane * 4); }
    for (; row < NROW; row += stride) {
        const int nrow = row + stride;
        if (nrow < NROW) { const float* xr = XROW(nrow);
#pragma unroll
            for (int i = 0; i < 4; ++i) vn[i] = *(const f32x4*)(xr + i * 256 + lane * 4); }
        const int cnd = row < SEQ ? 0 : row < NLAT ? 1 : 2;
        float ss = 0.f;
#pragma unroll
        for (int i = 0; i < 4; ++i) ss += v[i][0] * v[i][0] + v[i][1] * v[i][1] + v[i][2] * v[i][2] + v[i][3] * v[i][3];
        if (cnd != cur) { cur = cnd; const float* sh = modl + cnd * 3072; const float* sc = sh + 1024;
#pragma unroll
            for (int i = 0; i < 4; ++i) { const int col = i * 256 + lane * 4; ga[i] = *(const f32x4*)(g + col) * (*(const f32x4*)(sc + col) + 1.f); sb[i] = *(const f32x4*)(sh + col); } }
        ss = wave_sum(ss, lane); const float rstd = __builtin_amdgcn_rsqf(ss * (1.f / 1024.f) + EPS);
#pragma unroll
        for (int i = 0; i < 4; ++i) { const int col = i * 256 + lane * 4;
            const f32x4 o = v[i] * rstd * ga[i] + sb[i];
            u32x2 w = {cvtpk(o[0], o[1]), cvtpk(o[2], o[3])}; *(u32x2*)(p.HY + (size_t)row * DM + col) = w; }
#pragma unroll
        for (int i = 0; i < 4; ++i) v[i] = vn[i];
    }
#undef XROW
}
__device__ __forceinline__ void phase_final(CParams& p, int wv) {
    const int tid = tid_l(wv), wid = tid >> 6, lane = tid & 63, bid = bid_l();
    f32x4 fg[4];
#pragma unroll
    for (int i = 0; i < 4; ++i) fg[i] = *(const f32x4*)(p.final_g + i * 256 + lane * 4);
    const int stride = (int)gridDim.x * 8;
    f32x4 v[4], vn[4];
    int row = bid * 8 + wid;
    if (row < NLAT) { const float* xr = p.xlat + (size_t)row * DM;
#pragma unroll
        for (int i = 0; i < 4; ++i) v[i] = *(const f32x4*)(xr + i * 256 + lane * 4); }
    for (; row < NLAT; row += stride) {
        const int nrow = row + stride;
        if (nrow < NLAT) { const float* xr = p.xlat + (size_t)nrow * DM;
#pragma unroll
            for (int i = 0; i < 4; ++i) vn[i] = *(const f32x4*)(xr + i * 256 + lane * 4); }
        float* xw = p.xlat + (size_t)row * DM;
        float ss = 0.f;
#pragma unroll
        for (int i = 0; i < 4; ++i) ss += v[i][0] * v[i][0] + v[i][1] * v[i][1] + v[i][2] * v[i][2] + v[i][3] * v[i][3];
        ss = wave_sum(ss, lane); const float rstd = __builtin_amdgcn_rsqf(ss * (1.f / 1024.f) + EPS);
#pragma unroll
        for (int i = 0; i < 4; ++i) { const int col = i * 256 + lane * 4; *(f32x4*)(xw + col) = v[i] * rstd * fg[i]; }
#pragma unroll
        for (int i = 0; i < 4; ++i) v[i] = vn[i];
    }
}

__device__ __forceinline__ void phase_mix(CParams& p, int l, char* lds, int wv) {
    const int c = bid_l(), G = gridDim.x;
    const float* subg = p.subln_g + l * 128;
    const int nlat_u = (512 - c + G - 1) / G;
    for (int k = 0; k <= nlat_u; ++k) {
        int qrow0, b, h, NT;
        if (k < nlat_u) { const int u = c + k * G, bh = u & 7, qb = u >> 3; b = bh >> 2; h = bh & 3; qrow0 = b * SEQ + qb * 128; NT = 132; }
        else { const int u = (c + G - 16) % G; if (l == DEPTH - 1 || u >= 16) break; const int bh = u & 7, qb = u >> 3; b = bh >> 2; h = bh & 3; qrow0 = NLAT + b * CTXL + qb * 128; NT = 4; }
        at::attn_unit(p.P, p.HY, qrow0, b, h, NT, p.lam + l, subg, lds, (PG8_LAS unsigned char*)lds, wv);
    }
    const int nlight = (l < DEPTH - 1 ? NROW / 128 : NLAT / 128) * 2;
    const bool give = (l < DEPTH - 1) && G >= 48;
    int u = c; bool extra_done = false;
    for (;;) {
        int uu;
        if (u < nlight) { uu = u; u += G; if (give && uu >= 16 && uu < 32) continue; }
        else if (!extra_done) { extra_done = true; if (!(give && c >= 32 && c < 48)) break; uu = c - 16; }
        else break;
        light_unit(p, l, uu >> 1, uu & 1, lds, wv);
    }
}

__device__ __forceinline__ void ctx_outproj(CParams& p, int l, char* lds, int wv) {
    const int tid = tid_l(wv), wid = tid >> 6, lane = tid & 63, r32 = lane & 31, hi = lane >> 5;
    const float* xsrc = l == 0 ? p.ctx : p.xctx; const float* gate = p.mod + (size_t)(l * 3 + 2) * 3072 + 2048;
    float* part = (float*)lds;
    for (int u = bid_l(); u < 256; u += gridDim.x) {
        const int row0 = (u >> 4) * 32, col0 = (u & 15) * 64;
        const bf16_t* A = p.HY + (size_t)(NLAT + row0 + r32) * DM + wid * 128 + hi * 8;
        const bf16_t* B = p.WoutT + (size_t)l * DM * DM + (size_t)(col0 + r32) * DM + wid * 128 + hi * 8;
        f32x16 acc0 = {}, acc1 = {};
#pragma unroll
        for (int ks = 0; ks < 8; ++ks) {
            const bf16x8 a = *reinterpret_cast<const bf16x8*>(A + ks * 16), b0 = *reinterpret_cast<const bf16x8*>(B + ks * 16), b1 = *reinterpret_cast<const bf16x8*>(B + 32 * DM + ks * 16);
            acc0 = __builtin_amdgcn_mfma_f32_32x32x16_bf16(a, b0, acc0, 0, 0, 0); acc1 = __builtin_amdgcn_mfma_f32_32x32x16_bf16(a, b1, acc1, 0, 0, 0); }
#pragma unroll
        for (int r = 0; r < 16; ++r) { part[wid * 2048 + r * 64 + lane] = acc0[r]; part[wid * 2048 + 1024 + r * 64 + lane] = acc1[r]; }
        __syncthreads();
        float xs4[4], gt4[4];
#pragma unroll
        for (int j = 0; j < 4; ++j) { const int e = tid + 512 * j, cb = e >> 10, r = (e >> 6) & 15, ln = e & 63, row = row0 + at::crow(r, ln >> 5), col = col0 + cb * 32 + (ln & 31);
            xs4[j] = xsrc[(size_t)row * DM + col]; gt4[j] = gate[col]; }
#pragma unroll
        for (int j = 0; j < 4; ++j) { const int e = tid + 512 * j; float sum = 0.f;
#pragma unroll
            for (int w = 0; w < 8; ++w) sum += part[w * 2048 + e];
            const int cb = e >> 10, r = (e >> 6) & 15, ln = e & 63, row = row0 + at::crow(r, ln >> 5), col = col0 + cb * 32 + (ln & 31);
            p.xctx[(size_t)row * DM + col] = xs4[j] + gt4[j] * sum; }
        __syncthreads();
    }
}

#define XB_TMO      128
#define XB_XCNT(j)  (256  + 64 * (j))
#define XB_XSUB(j)  (1280 + 64 * (j))
#define XB_XGEN(j)  (2304 + 64 * (j))
#define XB_TOP      3328
#define XB_TOPGEN   3392
#define XB_WORDS    3456
#define XB_SPIN_CAP (1u << 18)
__device__ __forceinline__ unsigned xb_ld(unsigned* p)              { return __hip_atomic_load(p, __ATOMIC_RELAXED, __HIP_MEMORY_SCOPE_AGENT); }
__device__ __forceinline__ unsigned xb_add(unsigned* p, unsigned v) { return __hip_atomic_fetch_add(p, v, __ATOMIC_RELAXED, __HIP_MEMORY_SCOPE_AGENT); }
__device__ __forceinline__ unsigned xb_xcc_id() { return (unsigned)__builtin_amdgcn_s_getreg((3 << 11) | 20) & 0xFu; }
#define XB_SPIN(cond, bar) do { unsigned _sp = 0; while (cond) { __builtin_amdgcn_s_sleep(1); \
    if ((++_sp & 255u) == 0u) { if (xb_ld(&(bar)[XB_TMO])) break; if (_sp > XB_SPIN_CAP) { atomicAdd(&(bar)[XB_TMO], 1u); break; } } } } while (0)
__device__ __forceinline__ void xb_complete(unsigned* bar, unsigned x, unsigned& nloc, unsigned& nx) {
    const unsigned G = gridDim.x;
    unsigned sum, cnt, mine, sp = 0u;
    for (;;) {
        sum = 0u; cnt = 0u; mine = 0u;
#pragma unroll
        for (unsigned j = 0; j < 16; ++j) { const unsigned c = xb_ld(&bar[XB_XCNT(j)]); sum += c; cnt += (c > 0u) ? 1u : 0u; mine = (j == x) ? c : mine; }
        if (sum == G) break;
        __builtin_amdgcn_s_sleep(1);
        if ((++sp & 255u) == 0u) { if (xb_ld(&bar[XB_TMO])) break; if (sp > XB_SPIN_CAP) { atomicAdd(&bar[XB_TMO], 1u); break; } }
    }
    nloc = mine > 0u ? mine : 1u; nx = cnt > 0u ? cnt : 1u;
}
__device__ __forceinline__ void grid_bar(unsigned* bar, volatile PG8_LAS unsigned* st, int wv) {
    asm volatile("s_waitcnt vmcnt(0)" ::: "memory");
    __syncthreads();
    if (tid_l(wv) == 0) {
        __builtin_amdgcn_s_waitcnt(0);
        const unsigned x = xb_xcc_id();
        unsigned nloc = st[0], nx = st[1];
        if (nloc == 0u) { xb_complete(bar, x, nloc, nx); st[0] = nloc; st[1] = nx; }
        const unsigned old = xb_add(&bar[XB_XSUB(x)], 1u);
        const unsigned gen = old / nloc;
        if (old + 1u == (gen + 1u) * nloc) {
            __builtin_amdgcn_fence(__ATOMIC_RELEASE, "agent");
            asm volatile("s_waitcnt vmcnt(0)" ::: "memory");
            const unsigned og = xb_add(&bar[XB_TOP], 1u);
            const unsigned tg = og / nx;
            if (og + 1u == (tg + 1u) * nx) xb_add(&bar[XB_TOPGEN], 1u);
            else XB_SPIN(xb_ld(&bar[XB_TOPGEN]) == tg, bar);
            __builtin_amdgcn_fence(__ATOMIC_ACQUIRE, "agent");
            xb_add(&bar[XB_XGEN(x)], 1u);
            asm volatile("s_waitcnt vmcnt(0)" ::: "memory");
        } else {
            XB_SPIN(xb_ld(&bar[XB_XGEN(x)]) == gen, bar);
            __builtin_amdgcn_fence(__ATOMIC_ACQUIRE, "agent");
            asm volatile("s_waitcnt vmcnt(0)" ::: "memory");
        }
    }
    __syncthreads();
}

__global__ __launch_bounds__(512, 2) void mega(Params p_unused) {
    extern __shared__ __attribute__((aligned(16))) unsigned char shm[];
    const int wv = __builtin_amdgcn_readfirstlane((int)(threadIdx.x >> 6));
    volatile PG8_LAS unsigned* xst = (volatile PG8_LAS unsigned*)((PG8_LAS unsigned char*)shm + 131072 + 2048 + 64);
    {
        CParams& p = params_l();
        if (tid_l(wv) == 0) { xst[0] = 0u; xst[1] = 0u; (void)xb_add(&p.bar[XB_XCNT(xb_xcc_id())], 1u); }
        phase_prep(p, (char*)shm, wv);
        if (gridDim.x == 0x7fffffffu) cg::this_grid().sync();
        grid_bar(p.bar, xst, wv);
    }
#pragma clang loop unroll(disable)
    for (int l = 0; l < DEPTH; ++l) {
        { CParams& p = params_l(); phase_norm(p, l, wv); grid_bar(p.bar, xst, wv); }
        { CParams& p = params_l();
          pg8::Gemm g{p.HY, p.WinT + (size_t)l * DIN * DM, NROW, DIN, DM};
          pg8::StaticOrder S; S.init(g.M, g.N, (int)gridDim.x, bid_l());
          EpiIn E{p.P, p.rope};
          pg8::gemm_phase<EpiIn, pg8::StaticOrder>((PG8_LAS unsigned char*)shm, g, S, E, wv);
          if (l < DEPTH - 1) {
              const int Gi = (int)gridDim.x, nwg = (NROW / 256) * (DIN / 256), maxu = (nwg + Gi - 1) / Gi, nidle = Gi * maxu - nwg, c = bid_l();
              if (nidle == 0) convert_weights(p, l + 1, c, Gi, (char*)shm, wv);
              else if (c >= Gi - nidle) convert_weights(p, l + 1, c - (Gi - nidle), nidle, (char*)shm, wv);
          }
          grid_bar(p.bar, xst, wv); }
        { CParams& p = params_l(); phase_mix(p, l, (char*)shm, wv); grid_bar(p.bar, xst, wv); }
        { CParams& p = params_l();
          pg8::Gemm g{p.HY, p.WoutT + (size_t)l * DM * DM, NLAT, DM, DM};
          pg8::StaticOrder S; S.init(g.M, g.N, (int)gridDim.x, bid_l());
          EpiOut E{l == 0 ? p.x : p.xlat, l == 0 ? p.ctx : p.xctx, p.xlat, p.xctx, p.mod + (size_t)l * 3 * 3072};
          pg8::gemm_phase<EpiOut, pg8::StaticOrder>((PG8_LAS unsigned char*)shm, g, S, E, wv);
          if (l < DEPTH - 1) ctx_outproj(p, l, (char*)shm, wv);
          grid_bar(p.bar, xst, wv); }
    }
    { CParams& p = params_l(); phase_final(p, wv); }
}

constexpr size_t LDS_BYTES = 131072 + 2048 + 128;
static inline size_t al256(size_t x) { return (x + 255) / 256 * 256; }
extern "C" void kernel_launch(void* const* d_in, const int* in_sizes, int n_in, void* d_out, int out_size, void* d_ws, size_t ws_size, hipStream_t stream) {
    static int grid_blocks = 0;
    if (!grid_blocks) {
        int dev = 0, cus = 0, per_cu = 0;
        hipGetDevice(&dev);
        hipDeviceGetAttribute(&cus, hipDeviceAttributeMultiprocessorCount, dev);
        if (hipFuncSetAttribute((const void*)mega, hipFuncAttributeMaxDynamicSharedMemorySize, (int)LDS_BYTES) != hipSuccess) fprintf(stderr, "kernel_launch: hipFuncSetAttribute failed\n");
        hipOccupancyMaxActiveBlocksPerMultiprocessor(&per_cu, mega, 512, LDS_BYTES);
        if (per_cu < 1) per_cu = 1;
        if (cus < 1) cus = 256;
        grid_blocks = cus * (per_cu > 1 ? 1 : per_cu);
    }
    Params p{};
    p.x = (const float*)d_in[0]; p.c = (const float*)d_in[1]; p.ctx = (const float*)d_in[2]; p.c_ctx = (const float*)d_in[3]; p.w_mod = (const float*)d_in[4]; p.b_mod = (const float*)d_in[5];
    p.norm_g = (const float*)d_in[6]; p.w_in = (const float*)d_in[7]; p.w_out = (const float*)d_in[8]; p.sgu_g = (const float*)d_in[9]; p.sgu_w = (const float*)d_in[10]; p.sgu_b = (const float*)d_in[11];
    p.lq1 = (const float*)d_in[12]; p.lk1 = (const float*)d_in[13]; p.lq2 = (const float*)d_in[14]; p.lk2 = (const float*)d_in[15]; p.subln_g = (const float*)d_in[16];
    p.conv_w = (const float*)d_in[17]; p.conv_b = (const float*)d_in[18]; p.final_g = (const float*)d_in[19];
    char* w = (char*)d_ws; size_t off = 0;
    p.xlat = (float*)d_out;
    p.xctx = (float*)(w + off); off += al256((size_t)NCTX * DM * 4);
    p.WinT = (bf16_t*)(w + off); off += al256((size_t)DEPTH * DIN * DM * 2);
    p.WoutT = (bf16_t*)(w + off); off += al256((size_t)DEPTH * DM * DM * 2);
    p.mod = (float*)(w + off); off += al256((size_t)DEPTH * 3 * 3072 * 4);
    p.rope = (float*)(w + off); off += al256(4096 * 4);
    p.lam = (float*)(w + off); off += 256;
    p.bar = (unsigned*)(w + off); off += al256(XB_WORDS * 4);
    p.HY = (bf16_t*)(w + off); off += al256((size_t)NROW * DM * 2);
    p.P = (bf16_t*)(w + off); off += al256((size_t)NROW * DIN * 2);
    if (off > ws_size) { fprintf(stderr, "kernel_launch: workspace too small: need %zu have %zu\n", off, ws_size); return; }
    if (hipMemsetAsync(p.bar, 0, XB_WORDS * 4, stream) != hipSuccess) fprintf(stderr, "kernel_launch: hipMemsetAsync failed\n");
    void* args[] = {&p};
    hipError_t e = hipLaunchCooperativeKernel((const void*)mega, dim3(grid_blocks), dim3(512), args, LDS_BYTES, stream);
    if (e != hipSuccess) fprintf(stderr, "kernel_launch: cooperative launch failed: %s (grid %d)\n", hipGetErrorString(e), grid_blocks);
}
```

```cpp
#include <hip/hip_runtime.h>
#include <hip/hip_cooperative_groups.h>
#include <cstdio>
#include <cmath>
namespace cg = cooperative_groups;


constexpr int DM = 1024, NBATCH = 2, SEQ = 8192, DEPTH = 4, CTXL = 256;
constexpr int NLAT = NBATCH * SEQ, NCTX = NBATCH * CTXL, NROW = NLAT + NCTX;
constexpr int DIN = 3840;
constexpr int COL_AU = 0, COL_AV = 256, COL_AZ = 512, COL_Q = 768, COL_K = 1280, COL_V = 1792, COL_BZ = 2304, COL_CB = 2816, COL_CC = 3072, COL_CX = 3328, COL_CZ = 3584;
constexpr int YA = 0, YB = 256, YC = 768;
constexpr float EPS = 1e-6f;
constexpr int NPHASE = 2 + 4 * DEPTH;

typedef unsigned short bf16_t;
typedef short bf16x8 __attribute__((ext_vector_type(8)));
typedef short s16x4 __attribute__((ext_vector_type(4)));
typedef float f32x4 __attribute__((ext_vector_type(4)));
typedef float f32x16 __attribute__((ext_vector_type(16)));
typedef unsigned u32x4 __attribute__((ext_vector_type(4)));
typedef unsigned u32x2 __attribute__((ext_vector_type(2)));

struct Params {
    const float* x; const float* c; const float* ctx; const float* c_ctx; const float* w_mod; const float* b_mod; const float* norm_g;
    const float* w_in; const float* w_out; const float* sgu_g; const float* sgu_w; const float* sgu_b;
    const float* lq1; const float* lk1; const float* lq2; const float* lk2; const float* subln_g; const float* conv_w; const float* conv_b; const float* final_g;
    float* xlat;
    float* xctx;
    bf16_t* WinT;
    bf16_t* WoutT;
    float* mod;
    float* rope;
    float* lam;
    unsigned* bar;
    bf16_t* HY;
    bf16_t* P;
};

typedef const __attribute__((address_space(4))) Params CParams;
__device__ __forceinline__ CParams& params_l() { unsigned long long k = (unsigned long long)__builtin_amdgcn_kernarg_segment_ptr(); asm volatile("" : "+s"(k)); return *(CParams*)k; }
__device__ __forceinline__ int tid_l(int wv) { int t; asm volatile("v_mbcnt_lo_u32_b32 %0, -1, 0\n\tv_mbcnt_hi_u32_b32 %0, -1, %0\n\tv_lshl_or_b32 %0, %1, 6, %0" : "=&v"(t) : "s"(wv)); return t; }
__device__ __forceinline__ int bid_l() { int t = blockIdx.x; asm volatile("" : "+s"(t)); return t; }
__device__ __forceinline__ float shx(float v, int lane, int m) { return __int_as_float(__builtin_amdgcn_ds_bpermute((lane ^ m) << 2, __float_as_int(v))); }
#define DPP_ADD(v, CTRL) ((v) + __int_as_float(__builtin_amdgcn_update_dpp(0, __float_as_int(v), (CTRL), 0xf, 0xf, false)))
__device__ __forceinline__ float row16_sum(float v) { v = DPP_ADD(v, 0xB1); v = DPP_ADD(v, 0x4E); v = DPP_ADD(v, 0x141); v = DPP_ADD(v, 0x140); return v; }
__device__ __forceinline__ float swap32(float v, int hi) { auto rr = __builtin_amdgcn_permlane32_swap(__float_as_uint(v), __float_as_uint(v), false, false); return __uint_as_float(hi ? rr[0] : rr[1]); }
__device__ __forceinline__ float bf2f(short s) { return __uint_as_float(((unsigned)(unsigned short)s) << 16); }
__device__ __forceinline__ unsigned cvtpk(float lo, float hi) { unsigned r; asm volatile("v_cvt_pk_bf16_f32 %0, %1, %2" : "=v"(r) : "v"(lo), "v"(hi)); return r; }
__device__ __forceinline__ float silu_f(float x) { return x * __builtin_amdgcn_rcpf(1.f + __builtin_amdgcn_exp2f(-1.4426950408889634f * x)); }
__device__ __forceinline__ float gelu_f(float x) { const float z = x * (1.f + 0.044715f * x * x); return x * __builtin_amdgcn_rcpf(1.f + __builtin_amdgcn_exp2f(-2.3022081985f * z)); }

namespace pg8 {
#define PG8_LAS __attribute__((address_space(3)))
constexpr int BM = 256, BK = 64, HALF = 128, HTB = HALF * BK * 2, STAGE_BYTES = 8 * HTB, NXCD = 8, WGM = 8;
__device__ __forceinline__ int lds_byte(int r, int c) { const int st = (r >> 4) * 2 + (c >> 5), rr = r & 15, cc = c & 31, ob = rr * 64 + cc * 2; return st * 1024 + (ob ^ (((ob >> 9) & 1) << 5)); }
__device__ __forceinline__ void stage_rc(int b, int& R, int& C) { const int st = b / 1024, sb = b % 1024, swz = sb ^ (((sb >> 9) & 1) << 5); R = (st >> 1) * 16 + swz / 64; C = (st & 1) * 32 + (swz % 64) / 2; }
__device__ __forceinline__ int perm32(int rho) { const int n = rho >> 4, i = rho & 15; return 8 * (i >> 2) + 4 * n + (i & 3); }
struct Unit { int pm, pn; };
struct Gemm { const bf16_t* A; const bf16_t* Bt; int M, N, K; };
struct StaticOrder {
    int nM, nN, nwg, G, c;
    __device__ void init(int M, int N, int G_, int c_) { nM = M / BM; nN = N / BM; nwg = nM * nN; G = G_; c = c_; }
    __device__ bool next(int i, Unit& u) const {
        const long L = (long)i * G + c; if (L >= nwg) return false;
        int wgid = (int)L; { const int q = nwg / NXCD, r = nwg % NXCD, xcd = wgid % NXCD, off = wgid / NXCD; wgid = (xcd < r ? xcd * (q + 1) : r * (q + 1) + (xcd - r) * q) + off; }
        const int nig = WGM * nN, gid = wgid / nig, fm = gid * WGM, gsz = (nM - fm) < WGM ? (nM - fm) : WGM;
        u.pm = fm + ((wgid % nig) % gsz); u.pn = (wgid % nig) / gsz; return true;
    }
    __device__ __forceinline__ void a_ready(const Unit&) const {}
    __device__ __forceinline__ void done(const Unit&) const {}
};

template <class Epi, class Sched>
__device__ __forceinline__ void gemm_phase(PG8_LAS unsigned char* lds, const Gemm g, const Sched& S, const Epi& E, int wv) {
    const int tid = tid_l(wv), wid = __builtin_amdgcn_readfirstlane(tid >> 6), lane = tid & 63, wr = wid >> 2, wc = wid & 3, fr = lane & 15, fq = lane >> 4;
    const int K = g.K, nt = K / BK;
    unsigned voffA[2], voffB[2];
#pragma unroll
    for (int i = 0; i < 2; ++i) { int R, C; stage_rc(tid * 16 + i * 8192, R, C); const int Rb = Epi::PERM ? ((R & ~31) + perm32(R & 31)) : R;
        voffA[i] = (unsigned)(R * K + C) * 2u; voffB[i] = (unsigned)(Rb * K + C) * 2u; }
    const size_t kstep = (size_t)(BK * 2);
    const size_t hstep = (size_t)HALF * K * 2;
    const size_t tstep = 2 * hstep;
    const unsigned ldsw = (unsigned)wid * 1024u;
    const int aoff = lds_byte(wr * 64 + fr, fq * 8), boff = lds_byte(wc * 32 + fr, fq * 8);
#define PG8_SA(b, h) (((b) * 2 + (h)) * HTB)
#define PG8_SB(b, h) ((4 + (b) * 2 + (h)) * HTB)
#define PG8_STAGE(bufoff, gbase, voff) do { _Pragma("unroll") for (int _i = 0; _i < 2; ++_i) \
        __builtin_amdgcn_global_load_lds((const unsigned*)((const char*)(gbase) + (voff)[_i]), (PG8_LAS unsigned*)(lds + (bufoff) + ldsw + _i * 8192), 16, 0, 0); } while (0)
#define PG8_LDA(dst, b, h) do { _Pragma("unroll") for (int m = 0; m < 4; ++m) _Pragma("unroll") for (int k = 0; k < 2; ++k) dst[m][k] = *(const PG8_LAS bf16x8*)(lds + PG8_SA(b, h) + aoff + m * 2048 + k * 1024); } while (0)
#define PG8_LDB(dst, b, h) do { _Pragma("unroll") for (int n = 0; n < 2; ++n) _Pragma("unroll") for (int k = 0; k < 2; ++k) dst[n][k] = *(const PG8_LAS bf16x8*)(lds + PG8_SB(b, h) + boff + n * 2048 + k * 1024); } while (0)
#define PG8_MMA(ai, bj, At, Bt) do { __builtin_amdgcn_s_setprio(1); _Pragma("unroll") for (int m = 0; m < 4; ++m) _Pragma("unroll") for (int n = 0; n < 2; ++n) _Pragma("unroll") for (int k = 0; k < 2; ++k) \
        acc[ai][bj][m][n] = __builtin_amdgcn_mfma_f32_16x16x32_bf16(Bt[n][k], At[m][k], acc[ai][bj][m][n], 0, 0, 0); __builtin_amdgcn_s_setprio(0); } while (0)
#define PG8_WAIT_V(n) asm volatile("s_waitcnt vmcnt(" #n ")" ::: "memory")
#define PG8_WAIT_L(n) asm volatile("s_waitcnt lgkmcnt(" #n ")" ::: "memory")
#define PG8_BAR __builtin_amdgcn_s_barrier()
#define PG8_SCHED __builtin_amdgcn_sched_barrier(0)
    Unit cur, nxt; int ui = 0;
    if (!S.next(0, cur)) return;
    f32x4 acc[2][2][4][2];
#pragma unroll
    for (int a = 0; a < 2; ++a)
#pragma unroll
        for (int b = 0; b < 2; ++b)
#pragma unroll
            for (int m = 0; m < 4; ++m)
#pragma unroll
                for (int n = 0; n < 2; ++n) acc[a][b][m][n] = (f32x4){0.f, 0.f, 0.f, 0.f};
    bf16x8 At[4][2], B0[2][2], B1[2][2];
    const char* cA = (const char*)g.A + (size_t)cur.pm * tstep; const char* cB = (const char*)g.Bt + (size_t)cur.pn * tstep;
    S.a_ready(cur);
    PG8_STAGE(PG8_SB(0, 0), cB, voffB); PG8_STAGE(PG8_SA(0, 0), cA, voffA); PG8_STAGE(PG8_SB(0, 1), cB + hstep, voffB); PG8_STAGE(PG8_SA(0, 1), cA + hstep, voffA);
    if (wr == 1) PG8_BAR;
    PG8_WAIT_V(4); PG8_BAR;
    PG8_STAGE(PG8_SB(1, 0), cB + kstep, voffB); PG8_STAGE(PG8_SA(1, 0), cA + kstep, voffA); PG8_STAGE(PG8_SB(1, 1), cB + hstep + kstep, voffB);
    PG8_WAIT_V(6); PG8_BAR;
    for (;;) {
        const bool has_next = S.next(ui + 1, nxt);
        const char* nA = has_next ? (const char*)g.A + (size_t)nxt.pm * tstep : cA; const char* nB = has_next ? (const char*)g.Bt + (size_t)nxt.pn * tstep : cB;
        for (int t = 0; t < nt; t += 2) {
            const bool last = (t == nt - 2);
            const char* a1 = cA + (size_t)(t + 1) * kstep;
            const char* a2 = last ? nA : cA + (size_t)(t + 2) * kstep; const char* b2 = last ? nB : cB + (size_t)(t + 2) * kstep;
            const char* a3 = a2 + kstep; const char* b3 = b2 + kstep;
            if (last && has_next) S.a_ready(nxt);
            PG8_LDB(B0, 0, 0); PG8_SCHED; PG8_LDA(At, 0, 0); PG8_STAGE(PG8_SA(1, 1), a1 + hstep, voffA);
            PG8_WAIT_L(8); PG8_BAR; PG8_WAIT_L(0); PG8_MMA(0, 0, At, B0); PG8_BAR; PG8_SCHED;
            PG8_LDB(B1, 0, 1); PG8_STAGE(PG8_SB(0, 0), b2, voffB);
            PG8_BAR; PG8_WAIT_L(0); PG8_MMA(0, 1, At, B1); PG8_BAR;
            PG8_LDA(At, 0, 1); PG8_STAGE(PG8_SA(0, 0), a2, voffA);
            PG8_BAR; PG8_WAIT_L(0); PG8_MMA(1, 0, At, B0); PG8_BAR; PG8_SCHED;
            PG8_STAGE(PG8_SB(0, 1), b2 + hstep, voffB);
            PG8_WAIT_V(6); PG8_BAR; PG8_MMA(1, 1, At, B1); PG8_BAR;
            PG8_LDB(B0, 1, 0); PG8_SCHED; PG8_LDA(At, 1, 0); PG8_STAGE(PG8_SA(0, 1), a2 + hstep, voffA);
            PG8_WAIT_L(8); PG8_BAR; PG8_WAIT_L(0); PG8_MMA(0, 0, At, B0); PG8_BAR; PG8_SCHED;
            PG8_LDB(B1, 1, 1); PG8_STAGE(PG8_SB(1, 0), b3, voffB);
            PG8_BAR; PG8_WAIT_L(0); PG8_MMA(0, 1, At, B1); PG8_BAR;
            PG8_LDA(At, 1, 1); PG8_STAGE(PG8_SA(1, 0), a3, voffA);
            PG8_BAR; PG8_WAIT_L(0); PG8_MMA(1, 0, At, B0); PG8_BAR; PG8_SCHED;
            PG8_STAGE(PG8_SB(1, 1), b3 + hstep, voffB);
            PG8_WAIT_V(6); PG8_BAR; PG8_MMA(1, 1, At, B1); PG8_BAR;
        }
        E(acc, cur, wr, wc, fr, fq); S.done(cur);
        if (!has_next) break;
#pragma unroll
        for (int a = 0; a < 2; ++a)
#pragma unroll
            for (int b = 0; b < 2; ++b)
#pragma unroll
                for (int m = 0; m < 4; ++m)
#pragma unroll
                    for (int n = 0; n < 2; ++n) acc[a][b][m][n] = (f32x4){0.f, 0.f, 0.f, 0.f};
        cur = nxt; cA = nA; cB = nB; ++ui;
    }
    PG8_WAIT_V(0);
    if (wr == 0) PG8_BAR;
    PG8_BAR;
#undef PG8_SA
#undef PG8_SB
#undef PG8_STAGE
#undef PG8_LDA
#undef PG8_LDB
#undef PG8_MMA
#undef PG8_WAIT_V
#undef PG8_WAIT_L
#undef PG8_BAR
#undef PG8_SCHED
}
}

constexpr float at_QSCALE = 0.125f * 1.4426950408889634f;
struct EpiIn {
    static constexpr bool PERM = true;
    bf16_t* O; const float* rope;
    __device__ __forceinline__ void operator()(const f32x4 (&acc)[2][2][4][2], const pg8::Unit& u, int wr, int wc, int fr, int fq) const {
        const int pn = u.pn;
        const int row0 = u.pm * 256 + wr * 64 + fr, col0 = pn * 256 + wc * 32 + 8 * fq;
        const int fuse = (pn == 0 || pn == 2) ? 1 : (pn == 11 || pn == 14) ? 2 : (pn == 12 || pn == 13) ? 3 : 0;
        const int fcol = (fuse == 1 ? COL_AU + (pn == 2 ? 128 : 0) : fuse == 2 ? COL_CB + (pn == 14 ? 128 : 0) : COL_CC + (pn == 13 ? 128 : 0)) + wc * 32 + 8 * fq;
        const int act = (pn == 1) ? 1 : (pn == 9 || pn == 10) ? 2 : (pn >= 3 && pn <= 6 && u.pm < 64) ? 3 : 0;
        const int axis = wc & 1; const float sgn = fq < 2 ? -1.f : 1.f; const int p0 = 8 * (fq & 1), lane = fq * 16 + fr;
        if (fuse) {
#pragma unroll
            for (int ai = 0; ai < 2; ++ai)
#pragma unroll
                for (int m = 0; m < 4; ++m) {
                    const int row = row0 + ai * 128 + m * 16;
                    f32x4 a0 = acc[ai][0][m][0], a1 = acc[ai][0][m][1], b0 = acc[ai][1][m][0], b1 = acc[ai][1][m][1];
                    if (fuse == 1) {
#pragma unroll
                        for (int j = 0; j < 4; ++j) { a0[j] = gelu_f(a0[j]) * silu_f(b0[j]); a1[j] = gelu_f(a1[j]) * silu_f(b1[j]); } }
                    else if (fuse == 2) {
#pragma unroll
                        for (int j = 0; j < 4; ++j) { a0[j] *= silu_f(b0[j]); a1[j] *= silu_f(b1[j]); } }
                    else { a0 *= b0; a1 *= b1; }
                    u32x4 w; w.x = cvtpk(a0[0], a0[1]); w.y = cvtpk(a0[2], a0[3]); w.z = cvtpk(a1[0], a1[1]); w.w = cvtpk(a1[2], a1[3]);
                    *(u32x4*)(O + (size_t)row * DIN + fcol) = w; }
            return;
        }
        f32x4 rc0[4], rc1[4], rs0[4], rs1[4];
#pragma unroll
        for (int ai = 0; ai < 2; ++ai)
#pragma unroll
            for (int m = 0; m < 4; ++m) {
                const int row = row0 + ai * 128 + m * 16;
                bf16_t* rowp = O + (size_t)row * DIN + col0;
                f32x4 c0 = {1.f, 1.f, 1.f, 1.f}, c1 = c0, s0 = {0.f, 0.f, 0.f, 0.f}, s1 = s0;
                if (act == 3) {
                    if (axis ? (ai == 0) : (m == 0)) { const int t = row & (SEQ - 1); const int pos = axis ? (t & 63) : (t >> 6); const float* tp = rope + pos * 16 + p0;
                        const f32x4 tc0 = *(const f32x4*)tp, tc1 = *(const f32x4*)(tp + 4), ts0 = *(const f32x4*)(tp + 2048) * sgn, ts1 = *(const f32x4*)(tp + 2052) * sgn;
                        if (axis) { rc0[m] = tc0; rc1[m] = tc1; rs0[m] = ts0; rs1[m] = ts1; } else { rc0[0] = tc0; rc1[0] = tc1; rs0[0] = ts0; rs1[0] = ts1; } }
                    const int sel = axis ? m : 0; c0 = rc0[sel]; c1 = rc1[sel]; s0 = rs0[sel]; s1 = rs1[sel]; }
#pragma unroll
                for (int bj = 0; bj < 2; ++bj) {
                    f32x4 v0 = acc[ai][bj][m][0], v1 = acc[ai][bj][m][1];
                    if (act == 1) {
#pragma unroll
                        for (int j = 0; j < 4; ++j) { v0[j] = gelu_f(v0[j]); v1[j] = gelu_f(v1[j]); } }
                    else if (act == 2) {
#pragma unroll
                        for (int j = 0; j < 4; ++j) { v0[j] = silu_f(v0[j]); v1[j] = silu_f(v1[j]); } }
                    else if (act == 3) {
                        f32x4 q0, q1;
#pragma unroll
                        for (int j = 0; j < 4; ++j) { q0[j] = swap32(v0[j], fq >> 1); q1[j] = swap32(v1[j], fq >> 1); }
                        v0 = v0 * c0 + q0 * s0; v1 = v1 * c1 + q1 * s1; }
                    if (pn == 3 || pn == 4) { v0 *= at_QSCALE; v1 *= at_QSCALE; }
                    u32x4 w; w.x = cvtpk(v0[0], v0[1]); w.y = cvtpk(v0[2], v0[3]); w.z = cvtpk(v1[0], v1[1]); w.w = cvtpk(v1[2], v1[3]);
                    *(u32x4*)(rowp + bj * 128) = w; }
            }
    }
};
struct EpiOut {
    static constexpr bool PERM = false;
    const float* src_lat; const float* src_ctx; float* dst_lat; float* dst_ctx; const float* modl;
    __device__ __forceinline__ void operator()(const f32x4 (&acc)[2][2][4][2], const pg8::Unit& u, int wr, int wc, int fr, int fq) const {
        const int cnd = u.pm < 32 ? 0 : u.pm < 64 ? 1 : 2;
        const int lrow0 = (u.pm < 64 ? u.pm * 256 : (u.pm - 64) * 256) + wr * 64 + fr, col0 = u.pn * 256 + wc * 32 + 4 * fq;
        const float* sp = (u.pm < 64 ? src_lat : src_ctx); float* dp = (u.pm < 64 ? dst_lat : dst_ctx);
        const float* gate = modl + cnd * 3072 + 2048 + col0;
        f32x4 gv[2][2];
#pragma unroll
        for (int bj = 0; bj < 2; ++bj)
#pragma unroll
            for (int n = 0; n < 2; ++n) gv[bj][n] = *(const f32x4*)(gate + bj * 128 + n * 16);
#pragma unroll
        for (int ai = 0; ai < 2; ++ai) {
            f32x4 xs[4][2][2];
#pragma unroll
            for (int m = 0; m < 4; ++m) { const size_t ro = (size_t)(lrow0 + ai * 128 + m * 16) * DM + col0;
#pragma unroll
                for (int bj = 0; bj < 2; ++bj)
#pragma unroll
                    for (int n = 0; n < 2; ++n) xs[m][bj][n] = *(const f32x4*)(sp + ro + bj * 128 + n * 16); }
#pragma unroll
            for (int m = 0; m < 4; ++m) { const size_t ro = (size_t)(lrow0 + ai * 128 + m * 16) * DM + col0;
#pragma unroll
                for (int bj = 0; bj < 2; ++bj)
#pragma unroll
                    for (int n = 0; n < 2; ++n) *(f32x4*)(dp + ro + bj * 128 + n * 16) = xs[m][bj][n] + gv[bj][n] * acc[ai][bj][m][n]; }
        }
    }
};

namespace at {
constexpr int KVBLK = 64;
constexpr float QSCALE = 0.125f * 1.4426950408889634f;
constexpr float THR2 = 8.f * 1.4426950408889634f;
constexpr int SHM_V = KVBLK * 128 * 2, SHM_K = KVBLK * 128 * 2;
#define KSWZ(row, colB) ((row) * 256 + ((colB) ^ (((row) & 15) << 4)))
#define SBAR() __builtin_amdgcn_sched_barrier(0)
__device__ __forceinline__ int crow(int r, int hi) { return (r & 3) + 8 * (r >> 2) + 4 * hi; }
__device__ __forceinline__ void partialSM(f32x16& p0, f32x16& p1, float& m_reg, float& mn, float& alpha) {
    float pmax = p0[0];
#pragma unroll
    for (int r = 1; r < 16; ++r) pmax = fmaxf(pmax, p0[r]);
#pragma unroll
    for (int r = 0; r < 16; ++r) pmax = fmaxf(pmax, p1[r]);
    { auto rr = __builtin_amdgcn_permlane32_swap(__float_as_uint(pmax), __float_as_uint(pmax), false, false);
      pmax = fmaxf(__uint_as_float(rr[0]), __uint_as_float(rr[1])); }
    if (__builtin_expect(__all(pmax - m_reg <= THR2), 1)) { mn = m_reg; alpha = 1.f; }
    else { mn = fmaxf(m_reg, pmax); alpha = __builtin_amdgcn_exp2f(m_reg - mn); m_reg = mn; }
#pragma unroll
    for (int r = 0; r < 16; ++r) p0[r] -= mn;
#pragma unroll
    for (int r = 0; r < 16; ++r) p1[r] -= mn;
#pragma unroll
    for (int r = 0; r < 16; ++r) p0[r] = __builtin_amdgcn_exp2f(p0[r]);
}
__device__ __forceinline__ void finishSM(f32x16& p0, f32x16& p1, float alpha, float& l_reg, bf16x8& pa0, bf16x8& pa1, bf16x8& pa2, bf16x8& pa3) {
#pragma unroll
    for (int r = 0; r < 16; ++r) p1[r] = __builtin_amdgcn_exp2f(p1[r]);
    float ps = 0;
#pragma unroll
    for (int r = 0; r < 16; ++r) ps += p0[r];
#pragma unroll
    for (int r = 0; r < 16; ++r) ps += p1[r];
    { auto rr = __builtin_amdgcn_permlane32_swap(__float_as_uint(ps), __float_as_uint(ps), false, false);
      ps = __uint_as_float(rr[0]) + __uint_as_float(rr[1]); }
    l_reg = l_reg * alpha + ps;
#define PK4(P, BASE, OUT) do { unsigned a0 = cvtpk(P[BASE + 0], P[BASE + 1]), a1 = cvtpk(P[BASE + 2], P[BASE + 3]);   \
    unsigned b0 = cvtpk(P[BASE + 4], P[BASE + 5]), b1 = cvtpk(P[BASE + 6], P[BASE + 7]);                              \
    auto r0 = __builtin_amdgcn_permlane32_swap(a0, b0, false, false); auto r1 = __builtin_amdgcn_permlane32_swap(a1, b1, false, false); \
    u32x4 w = {r0[0], r1[0], r0[1], r1[1]}; OUT = *reinterpret_cast<bf16x8*>(&w); } while (0)
    PK4(p0, 0, pa0); PK4(p0, 8, pa1); PK4(p1, 0, pa2); PK4(p1, 8, pa3);
#undef PK4
}
__device__ __forceinline__ void qkt(f32x16& p0, f32x16& p1, const char* Ks, const bf16x8* qr, int r32, int hi, int mcolB) {
    p0 = f32x16{}; p1 = f32x16{};
#pragma unroll
    for (int d0 = 0; d0 < 4; ++d0) { const int cb = mcolB + (d0 * 16 + hi * 8) * 2;
        const bf16x8 b0 = *reinterpret_cast<const bf16x8*>(Ks + KSWZ(r32, cb));
        const bf16x8 b1 = *reinterpret_cast<const bf16x8*>(Ks + KSWZ(32 + r32, cb));
        p0 = __builtin_amdgcn_mfma_f32_32x32x16_bf16(b0, qr[d0], p0, 0, 0, 0);
        p1 = __builtin_amdgcn_mfma_f32_32x32x16_bf16(b1, qr[d0], p1, 0, 0, 0); }
}
__device__ __forceinline__ int v_st(int k, int c) { const int kk = (k & ~0xC) | ((k & 4) << 1) | ((k & 8) >> 1); return ((kk >> 3) * 4 + (c >> 5)) * 512 + ((kk & 7) * 32 + (c & 31)) * 2; }
__device__ __forceinline__ int v_rd_base(int lane) { return ((lane & 3) << 3) | (((lane >> 2) & 3) << 6) | (((lane >> 4) & 1) << 5) | (((lane >> 5) & 1) << 8); }
constexpr int v_rd_off(int d0, int ks, int half) { return d0 * 512 + ks * 4096 + half * 2048; }
template <int OFF> __device__ __forceinline__ s16x4 tr_read(int vb) {
    s16x4 r; asm volatile("ds_read_b64_tr_b16 %0, %1 offset:%2" : "=&v"(r) : "v"(vb), "i"(OFF) : "memory"); return r;
}
template <int D0> __device__ __forceinline__ void pv_one(f32x16& od, int vb, bf16x8 pa0, bf16x8 pa1, bf16x8 pa2, bf16x8 pa3) {
    const s16x4 l0 = tr_read<v_rd_off(D0, 0, 0)>(vb), h0 = tr_read<v_rd_off(D0, 0, 1)>(vb), l1 = tr_read<v_rd_off(D0, 1, 0)>(vb), h1 = tr_read<v_rd_off(D0, 1, 1)>(vb);
    const s16x4 l2 = tr_read<v_rd_off(D0, 2, 0)>(vb), h2 = tr_read<v_rd_off(D0, 2, 1)>(vb), l3 = tr_read<v_rd_off(D0, 3, 0)>(vb), h3 = tr_read<v_rd_off(D0, 3, 1)>(vb);
    asm volatile("s_waitcnt lgkmcnt(0)" ::: "memory"); SBAR();
#define PK(L, H) (bf16x8){L[0], L[1], L[2], L[3], H[0], H[1], H[2], H[3]}
    od = __builtin_amdgcn_mfma_f32_32x32x16_bf16(pa0, PK(l0, h0), od, 0, 0, 0);
    od = __builtin_amdgcn_mfma_f32_32x32x16_bf16(pa1, PK(l1, h1), od, 0, 0, 0);
    od = __builtin_amdgcn_mfma_f32_32x32x16_bf16(pa2, PK(l2, h2), od, 0, 0, 0);
    od = __builtin_amdgcn_mfma_f32_32x32x16_bf16(pa3, PK(l3, h3), od, 0, 0, 0);
#undef PK
}
__device__ __forceinline__ void pv_d0(f32x16* o, int vb, bf16x8 pa0, bf16x8 pa1, bf16x8 pa2, bf16x8 pa3) {
    pv_one<0>(o[0], vb, pa0, pa1, pa2, pa3); pv_one<1>(o[1], vb, pa0, pa1, pa2, pa3); pv_one<2>(o[2], vb, pa0, pa1, pa2, pa3); pv_one<3>(o[3], vb, pa0, pa1, pa2, pa3);
}

__device__ __forceinline__ void attn_epilogue(f32x16* o, float l_full, const bf16_t* __restrict__ Pb, bf16_t* __restrict__ Yb, int qrow0, int h, const float* __restrict__ lamp, const float* __restrict__ subg, char* lds, float* li_l, int wv) {
    const float lam = lamp[0], obs = lamp[DEPTH];
    const int tid = tid_l(wv), wid = tid >> 6, lane = tid & 63, r32 = lane & 31, hi = lane >> 5, rg = wid & 3, mm = wid >> 2;
    if (hi == 0) li_l[r32] = l_full; asm volatile("s_waitcnt lgkmcnt(0)" ::: "memory");
    float rli[16];
#pragma unroll
    for (int r = 0; r < 16; ++r) rli[r] = __builtin_amdgcn_rcpf(li_l[crow(r, hi)]);
    float* cbuf = (float*)lds + rg * 4096 + lane;
    bf16x8 gz[4];
#pragma unroll
    for (int jj = 0; jj < 4; ++jj) { const int c = tid + 512 * jj, row = c >> 4, col8 = (c & 15) * 8;
        gz[jj] = *reinterpret_cast<const bf16x8*>(Pb + (size_t)(qrow0 + row) * DIN + COL_BZ + h * 128 + col8); }
    if (mm == 1) {
#pragma unroll
        for (int d0 = 0; d0 < 4; ++d0)
#pragma unroll
            for (int r = 0; r < 16; ++r) cbuf[(d0 * 16 + r) * 64] = -lam * o[d0][r] * rli[r];
    }
    __syncthreads();
    if (mm == 0) {
        float ss[16];
#pragma unroll
        for (int r = 0; r < 16; ++r) ss[r] = 0.f;
#pragma unroll
        for (int d0 = 0; d0 < 4; ++d0)
#pragma unroll
            for (int r = 0; r < 16; ++r) { const float v = o[d0][r] * rli[r] + cbuf[(d0 * 16 + r) * 64]; o[d0][r] = v; ss[r] += v * v; }
#pragma unroll
        for (int r = 0; r < 16; ++r) { float sq = row16_sum(ss[r]); sq += shx(sq, lane, 16);
            ss[r] = __builtin_amdgcn_rsqf(sq * (1.f / 128.f) + EPS) * obs; }
#pragma unroll
        for (int d0 = 0; d0 < 4; ++d0) { const float gs = subg[d0 * 32 + r32];
#pragma unroll
            for (int r = 0; r < 16; ++r) cbuf[(d0 * 16 + r) * 64] = o[d0][r] * ss[r] * gs; }
    }
    __syncthreads();
    {
        const float* cb0 = (const float*)lds;
#pragma unroll
        for (int jj = 0; jj < 4; ++jj) { const int c = tid + 512 * jj, row = c >> 4, col8 = (c & 15) * 8;
            const int d0 = col8 >> 5, rb = col8 & 31, rgq = row >> 5, within = row & 31, hiq = (within >> 2) & 1, r = (within & 3) + 4 * (within >> 3);
            const float* mp = cb0 + ((rgq * 4 + d0) * 16 + r) * 64 + hiq * 32 + rb;
            const f32x4 m0 = *(const f32x4*)mp, m1 = *(const f32x4*)(mp + 4);
            u32x4 w = {cvtpk(m0[0] * bf2f(gz[jj][0]), m0[1] * bf2f(gz[jj][1])), cvtpk(m0[2] * bf2f(gz[jj][2]), m0[3] * bf2f(gz[jj][3])),
                       cvtpk(m1[0] * bf2f(gz[jj][4]), m1[1] * bf2f(gz[jj][5])), cvtpk(m1[2] * bf2f(gz[jj][6]), m1[3] * bf2f(gz[jj][7]))};
            *(u32x4*)(Yb + (size_t)(qrow0 + row) * DM + YB + h * 128 + col8) = w; }
    }
    __syncthreads();
}

__device__ __forceinline__ void attn_unit_exact(const bf16_t* __restrict__ Pb, bf16_t* __restrict__ Yb, int qrow0, int b, int h, int NT, const float* __restrict__ lamp, const float* __restrict__ subg, char* lds, int wv) {
    const int tid = tid_l(wv), wid = tid >> 6, lane = tid & 63, r32 = lane & 31, hi = lane >> 5, rg = wid & 3, mm = wid >> 2;
    char* V_lds = lds; char* K_lds = lds + 2 * SHM_V;
    float* wsl = (float*)(lds + 8 * SHM_V) + wid * 64; float* li_l = wsl; float* al_l = wsl + 32;
    float m_reg = -1e30f, l_reg = 0; f32x16 o[4] = {}; bf16x8 qr[4];
    const bf16_t* Qw = Pb + (size_t)(qrow0 + rg * 32 + r32) * DIN + COL_Q + h * 128 + mm * 64 + hi * 8;
#pragma unroll
    for (int d0 = 0; d0 < 4; ++d0) qr[d0] = *reinterpret_cast<const bf16x8*>(Qw + d0 * 16);
    const int sr = tid >> 4, sc = (tid & 15) * 8, vst0 = v_st(sr, sc), vst1 = v_st(32 + sr, sc);
    const int vb0 = (int)(uintptr_t)V_lds + v_rd_base(lane);
    const int mcolB = mm * 128;
    const bf16_t* kvc = Pb + (size_t)(NLAT + b * CTXL + sr) * DIN + h * 128 + sc;
    const bf16_t* kvl = Pb + (size_t)(b * SEQ + sr) * DIN + h * 128 + sc - (size_t)256 * DIN;
    struct { bf16x8 vs0, vs1, ks0, ks1; } sr_[1];
#define SLOAD(i, j) do { const bf16_t* _b = ((j) < 4 ? kvc : kvl) + (size_t)(j) * 64 * DIN; \
    sr_[i].vs0 = *reinterpret_cast<const bf16x8*>(_b + COL_V); sr_[i].vs1 = *reinterpret_cast<const bf16x8*>(_b + COL_V + 32 * DIN); \
    sr_[i].ks0 = *reinterpret_cast<const bf16x8*>(_b + COL_K); sr_[i].ks1 = *reinterpret_cast<const bf16x8*>(_b + COL_K + 32 * DIN); } while (0)
#define SWRITE(bb, i) do { *(bf16x8*)(V_lds + (bb) * SHM_V + vst0) = sr_[i].vs0;          \
    *(bf16x8*)(V_lds + (bb) * SHM_V + vst1) = sr_[i].vs1; const int kc = sc * 2;               \
    *(bf16x8*)(K_lds + (bb) * SHM_K + KSWZ(sr, kc)) = sr_[i].ks0;                       \
    *(bf16x8*)(K_lds + (bb) * SHM_K + KSWZ(32 + sr, kc)) = sr_[i].ks1; } while (0)
#define SWAIT() asm volatile("s_waitcnt vmcnt(4)" ::: "memory")
#define RESC(a) do { if (__any((a) < 1.f)) { if (hi == 0) al_l[r32] = (a); asm volatile("s_waitcnt lgkmcnt(0)" ::: "memory"); \
    _Pragma("unroll") for (int d = 0; d < 4; ++d) _Pragma("unroll") for (int r = 0; r < 16; ++r) o[d][r] *= al_l[crow(r, hi)]; } } while (0)
    f32x16 p0, p1; float mn, al; bf16x8 pa0, pa1, pa2, pa3;
    for (int j = 0; j < NT; ++j) {
        SLOAD(0, j); asm volatile("s_waitcnt vmcnt(0)" ::: "memory"); SWRITE(0, 0); __syncthreads();
        qkt(p0, p1, K_lds, qr, r32, hi, mcolB); partialSM(p0, p1, m_reg, mn, al);
        RESC(al);
        finishSM(p0, p1, al, l_reg, pa0, pa1, pa2, pa3); SBAR();
        pv_d0(o, vb0, pa0, pa1, pa2, pa3);
        __syncthreads();
    }
    attn_epilogue(o, l_reg, Pb, Yb, qrow0, h, lamp, subg, lds, li_l, wv);
#undef SLOAD
#undef SWRITE
#undef SWAIT
#undef RESC
}

__device__ __forceinline__ void attn_unit(const bf16_t* __restrict__ Pb, bf16_t* __restrict__ Yb, int qrow0, int b, int h, int NT, const float* __restrict__ lamp, const float* __restrict__ subg, char* lds, PG8_LAS unsigned char* ldsa, int wv) {
    const int tid = tid_l(wv), wid = __builtin_amdgcn_readfirstlane(tid >> 6), lane = tid & 63, r32 = lane & 31, hi = lane >> 5, rg = wid & 3, mm = wid >> 2;
    char* V_lds = lds; char* K_lds = lds + 4 * SHM_V;
    float* li_l = (float*)(lds + 8 * SHM_V) + wid * 64;
    float l_acc = 0.f; f32x16 o[4] = {}; bf16x8 qr[4];
    const bf16_t* Qw = Pb + (size_t)(qrow0 + rg * 32 + r32) * DIN + COL_Q + h * 128 + mm * 64 + hi * 8;
#pragma unroll
    for (int d0 = 0; d0 < 4; ++d0) qr[d0] = *reinterpret_cast<const bf16x8*>(Qw + d0 * 16);
    const int vb0 = (int)(uintptr_t)V_lds + v_rd_base(lane);
    const int mcolB = mm * 128;
    unsigned koff[2], voff[2];
#pragma unroll
    for (int i = 0; i < 2; ++i) { const int ci = wid * 128 + i * 64 + lane;
        { const int row = ci >> 4, cc = (ci & 15) ^ (row & 15); koff[i] = (unsigned)(row * DIN + COL_K + h * 128 + cc * 8) * 2u; }
        { const int sub = ci >> 5, k = (sub >> 2) * 8 + ((ci & 31) >> 2), c = (sub & 3) * 32 + (ci & 3) * 8; voff[i] = (unsigned)(k * DIN + COL_V + h * 128 + c) * 2u; } }
    const bf16_t* kvc = Pb + (size_t)(NLAT + b * CTXL) * DIN;
    const bf16_t* kvl = Pb + (size_t)(b * SEQ) * DIN - (size_t)256 * DIN;
#define KVBASE(t) ((const char*)(((t) < 4 ? kvc : kvl) + (size_t)(t) * 64 * DIN))
#define DMAV2(t, tb) do { const char* _b = KVBASE(t); const int _bo = ((tb) & 3) * SHM_V + wid * 2048; \
    _Pragma("unroll") for (int _i = 0; _i < 2; ++_i) __builtin_amdgcn_global_load_lds((const unsigned*)(_b + voff[_i]), (PG8_LAS unsigned*)(ldsa + _bo + _i * 1024), 16, 0, 0); } while (0)
#define DMAK2(t, tb) do { const char* _b = KVBASE(t); const int _bo = ((tb) & 3) * SHM_V + wid * 2048; \
    _Pragma("unroll") for (int _i = 0; _i < 2; ++_i) __builtin_amdgcn_global_load_lds((const unsigned*)(_b + koff[_i]), (PG8_LAS unsigned*)(ldsa + 4 * SHM_V + _bo + _i * 1024), 16, 0, 0); } while (0)
#define BOFF(t) (((t) & 3) * SHM_V)
#define QKTF(P0, P1, Ks) do { _Pragma("unroll") for (int d0 = 0; d0 < 4; ++d0) { const int cb = mcolB + (d0 * 16 + hi * 8) * 2; \
        const bf16x8 kb0 = *reinterpret_cast<const bf16x8*>((Ks) + KSWZ(r32, cb)); const bf16x8 kb1 = *reinterpret_cast<const bf16x8*>((Ks) + KSWZ(32 + r32, cb)); \
        P0 = __builtin_amdgcn_mfma_f32_32x32x16_bf16(kb0, qr[d0], d0 == 0 ? NI : P0, 0, 0, 0); P1 = __builtin_amdgcn_mfma_f32_32x32x16_bf16(kb1, qr[d0], d0 == 0 ? NI : P1, 0, 0, 0); \
        if (d0 == 1) SBAR(); } } while (0)
#define EXPH(P) do { _Pragma("unroll") for (int r = 0; r < 16; ++r) P[r] = __builtin_amdgcn_exp2f(P[r]); } while (0)
#define PK4(P, BASE, OUT) do { unsigned a0 = cvtpk(P[BASE + 0], P[BASE + 1]), a1 = cvtpk(P[BASE + 2], P[BASE + 3]);   \
    unsigned b0 = cvtpk(P[BASE + 4], P[BASE + 5]), b1 = cvtpk(P[BASE + 6], P[BASE + 7]);                              \
    auto r0 = __builtin_amdgcn_permlane32_swap(a0, b0, false, false); auto r1 = __builtin_amdgcn_permlane32_swap(a1, b1, false, false); \
    u32x4 w = {r0[0], r1[0], r0[1], r1[1]}; OUT = *reinterpret_cast<bf16x8*>(&w); } while (0)
#define FINF(P0, P1) do { EXPH(P1); float s0 = P0[0] + P1[0], s1 = P0[1] + P1[1], s2 = P0[2] + P1[2], s3 = P0[3] + P1[3]; \
    _Pragma("unroll") for (int r = 4; r < 16; r += 4) { s0 += P0[r] + P1[r]; s1 += P0[r + 1] + P1[r + 1]; s2 += P0[r + 2] + P1[r + 2]; s3 += P0[r + 3] + P1[r + 3]; } \
    l_acc += (s0 + s1) + (s2 + s3); PK4(P0, 0, pa0); PK4(P0, 8, pa1); PK4(P1, 0, pa2); PK4(P1, 8, pa3); } while (0)
    f32x16 pA0, pA1, pB0, pB1, NI; bf16x8 pa0, pa1, pa2, pa3;
    const int kbase = (int)(uintptr_t)K_lds;
    const int kad0 = kbase + KSWZ(r32, mcolB + (0 * 16 + hi * 8) * 2), kad1 = kbase + KSWZ(r32, mcolB + (1 * 16 + hi * 8) * 2),
              kad2 = kbase + KSWZ(r32, mcolB + (2 * 16 + hi * 8) * 2), kad3 = kbase + KSWZ(r32, mcolB + (3 * 16 + hi * 8) * 2);
#define RBAR() do { asm volatile("" ::: "memory"); __builtin_amdgcn_s_barrier(); asm volatile("" ::: "memory"); } while (0)
    DMAK2(0, 0); DMAK2(1, 1); DMAK2(2, 2); DMAV2(0, 0); DMAV2(1, 1);
    asm volatile("s_waitcnt vmcnt(0)" ::: "memory"); RBAR();
    {
        qkt(pA0, pA1, K_lds, qr, r32, hi, mcolB);
        float pmax = pA0[0];
#pragma unroll
        for (int r = 1; r < 16; ++r) pmax = fmaxf(pmax, pA0[r]);
#pragma unroll
        for (int r = 0; r < 16; ++r) pmax = fmaxf(pmax, pA1[r]);
        { auto rr = __builtin_amdgcn_permlane32_swap(__float_as_uint(pmax), __float_as_uint(pmax), false, false); pmax = fmaxf(__uint_as_float(rr[0]), __uint_as_float(rr[1])); }
#pragma unroll
        for (int r = 0; r < 16; ++r) NI[r] = -pmax;
    }
    QKTF(pA0, pA1, K_lds); EXPH(pA0);
#define EXP4(P, B) do { P[B] = __builtin_amdgcn_exp2f(P[B]); P[B + 1] = __builtin_amdgcn_exp2f(P[B + 1]); P[B + 2] = __builtin_amdgcn_exp2f(P[B + 2]); P[B + 3] = __builtin_amdgcn_exp2f(P[B + 3]); } while (0)
#define KFR(d0, half) (*reinterpret_cast<const bf16x8*>(_ks + KSWZ((half) * 32 + r32, mcolB + ((d0) * 16 + hi * 8) * 2)))
#define LOADG(F, KS, VB) do { F##0l = tr_read<v_rd_off(0, KS, 0)>(VB); F##0h = tr_read<v_rd_off(0, KS, 1)>(VB); F##1l = tr_read<v_rd_off(1, KS, 0)>(VB); F##1h = tr_read<v_rd_off(1, KS, 1)>(VB); \
    F##2l = tr_read<v_rd_off(2, KS, 0)>(VB); F##2h = tr_read<v_rd_off(2, KS, 1)>(VB); F##3l = tr_read<v_rd_off(3, KS, 0)>(VB); F##3h = tr_read<v_rd_off(3, KS, 1)>(VB); } while (0)
#define PIN(x) asm volatile("" : "+v"(x))
#define EXP2E(P, i) do { P[i] = __builtin_amdgcn_exp2f(P[i]); P[(i) + 1] = __builtin_amdgcn_exp2f(P[(i) + 1]); } while (0)
#define SWP(r, a, b) do { auto _r = __builtin_amdgcn_permlane32_swap(a, b, false, false); r##x = _r[0]; r##y = _r[1]; PIN(r##x); PIN(r##y); } while (0)
#define MKPA(OUT, r0, r1) do { u32x4 _w = {r0##x, r1##x, r0##y, r1##y}; OUT = *reinterpret_cast<bf16x8*>(&_w); PIN(OUT); } while (0)
#define QKM(N, kf, d0, C) do { PIN(kf); N = __builtin_amdgcn_mfma_f32_32x32x16_bf16(kf, qr[d0], C, 0, 0, 0); PIN(N); } while (0)
#define PKN(OUT, P, B) do { u32x4 _w = {cvtpk(P[B], P[B + 1]), cvtpk(P[B + 2], P[B + 3]), cvtpk(P[B + 4], P[B + 5]), cvtpk(P[B + 6], P[B + 7])}; OUT = *reinterpret_cast<bf16x8*>(&_w); PIN(OUT); } while (0)
#define PKH(W, P, B) do { W = cvtpk(P[B], P[B + 1]); } while (0)
#define KRD(dst, addr, OFF) asm volatile("ds_read_b128 %0, %1 offset:" #OFF : "=&v"(dst) : "v"(addr) : "memory")
#define WAITK(n, ka, kb) asm volatile("s_waitcnt lgkmcnt(" #n ")" : "+v"(ka), "+v"(kb) :: "memory")
#define H1STEP(P0, P1, N0, N1, KOFF, VBN) do { const int _ko = (KOFF); unsigned _w0, _w1, _w2, _w3; bf16x8 k00, k01, k10, k11, k20, k21, k30, k31; \
    { const int _a0 = kad0 + _ko, _a1 = kad1 + _ko, _a2 = kad2 + _ko, _a3 = kad3 + _ko; \
      KRD(k00, _a0, 0); KRD(k01, _a0, 8192); KRD(k10, _a1, 0); KRD(k11, _a1, 8192); KRD(k20, _a2, 0); KRD(k21, _a2, 8192); KRD(k30, _a3, 0); KRD(k31, _a3, 8192); } \
    PIN(P1); PIN(P0); \
    WAITK(6, k00, k01); \
    QKM(N0, k00, 0, NI); EXP2E(P1, 0);  PIN(P1); PKH(_w0, P0, 0); \
    QKM(N1, k01, 0, NI); EXP2E(P1, 2);  PIN(P1); PKH(_w1, P0, 2); \
    WAITK(4, k10, k11); \
    QKM(N0, k10, 1, N0); EXP2E(P1, 4);  PIN(P1); PKH(_w2, P0, 4); \
    QKM(N1, k11, 1, N1); EXP2E(P1, 6);  PIN(P1); PKH(_w3, P0, 6); { u32x4 _w = {_w0, _w1, _w2, _w3}; pa0 = *reinterpret_cast<bf16x8*>(&_w); PIN(pa0); } \
    WAITK(2, k20, k21); \
    QKM(N0, k20, 2, N0); EXP2E(P1, 8);  PIN(P1); PKH(_w0, P0, 8); \
    QKM(N1, k21, 2, N1); EXP2E(P1, 10); PIN(P1); PKH(_w1, P0, 10); \
    WAITK(0, k30, k31); \
    QKM(N0, k30, 3, N0); EXP2E(P1, 12); PIN(P1); PKH(_w2, P0, 12); \
    QKM(N1, k31, 3, N1); EXP2E(P1, 14); PIN(P1); PKH(_w3, P0, 14); { u32x4 _w = {_w0, _w1, _w2, _w3}; pa1 = *reinterpret_cast<bf16x8*>(&_w); PIN(pa1); } \
    LOADG(fa, 0, VBN); LOADG(fb, 1, VBN); } while (0)
#define PKV(L, H) (bf16x8){L[0], L[1], L[2], L[3], H[0], H[1], H[2], H[3]}
#define PVM(i, PA, FL, FH) do { o[i] = __builtin_amdgcn_mfma_f32_32x32x16_bf16(PA, PKV(FL, FH), o[i], 0, 0, 0); PIN(o[i]); } while (0)
#define SUM2(g, A0, A1) do { _s0 += A0[2 * (g)] + A1[2 * (g)]; _s1 += A0[2 * (g) + 1] + A1[2 * (g) + 1]; PIN(_s0); PIN(_s1); } while (0)
#define WAITL(n, F) asm volatile("s_waitcnt lgkmcnt(" #n ")" : "+v"(F##0l), "+v"(F##0h), "+v"(F##1l), "+v"(F##1h), "+v"(F##2l), "+v"(F##2h), "+v"(F##3l), "+v"(F##3h) :: "memory")
#define H2STEP(VB, P0, P1, N0) do { const int _vb = (VB); unsigned _w0, _w1, _w2, _w3; float _s0 = 0.f, _s1 = 0.f; \
    PIN(N0); PIN(P1); \
    WAITL(8, fa); \
    PVM(0, pa0, fa0l, fa0h); SUM2(0, P0, P1); PKH(_w0, P1, 0); \
    PVM(1, pa0, fa1l, fa1h); SUM2(1, P0, P1); PKH(_w1, P1, 2); \
    PVM(2, pa0, fa2l, fa2h); SUM2(2, P0, P1); PKH(_w2, P1, 4); \
    PVM(3, pa0, fa3l, fa3h); SUM2(3, P0, P1); PKH(_w3, P1, 6); { u32x4 _w = {_w0, _w1, _w2, _w3}; pa2 = *reinterpret_cast<bf16x8*>(&_w); PIN(pa2); } \
    LOADG(fa, 2, _vb); WAITL(8, fb); \
    PVM(0, pa1, fb0l, fb0h); SUM2(4, P0, P1); PKH(_w0, P1, 8); \
    PVM(1, pa1, fb1l, fb1h); SUM2(5, P0, P1); PKH(_w1, P1, 10); \
    PVM(2, pa1, fb2l, fb2h); SUM2(6, P0, P1); PKH(_w2, P1, 12); \
    PVM(3, pa1, fb3l, fb3h); SUM2(7, P0, P1); PKH(_w3, P1, 14); { u32x4 _w = {_w0, _w1, _w2, _w3}; pa3 = *reinterpret_cast<bf16x8*>(&_w); PIN(pa3); } l_acc += _s0 + _s1; PIN(l_acc); \
    LOADG(fb, 3, _vb); WAITL(8, fa); \
    PVM(0, pa2, fa0l, fa0h); EXP2E(N0, 0);  PIN(N0); \
    PVM(1, pa2, fa1l, fa1h); EXP2E(N0, 2);  PIN(N0); \
    PVM(2, pa2, fa2l, fa2h); EXP2E(N0, 4);  PIN(N0); \
    PVM(3, pa2, fa3l, fa3h); EXP2E(N0, 6);  PIN(N0); \
    WAITL(0, fb); \
    PVM(0, pa3, fb0l, fb0h); EXP2E(N0, 8);  PIN(N0); \
    PVM(1, pa3, fb1l, fb1h); EXP2E(N0, 10); PIN(N0); \
    PVM(2, pa3, fb2l, fb2h); EXP2E(N0, 12); PIN(N0); \
    PVM(3, pa3, fb3l, fb3h); EXP2E(N0, 14); PIN(N0); } while (0)
#define H1LAST(P0, P1, VBN) do { unsigned _w0, _w1, _w2, _w3; \
    PIN(P1); PIN(P0); \
    EXP2E(P1, 0);  PIN(P1); PKH(_w0, P0, 0); \
    EXP2E(P1, 2);  PIN(P1); PKH(_w1, P0, 2); \
    EXP2E(P1, 4);  PIN(P1); PKH(_w2, P0, 4); \
    EXP2E(P1, 6);  PIN(P1); PKH(_w3, P0, 6); { u32x4 _w = {_w0, _w1, _w2, _w3}; pa0 = *reinterpret_cast<bf16x8*>(&_w); PIN(pa0); } \
    EXP2E(P1, 8);  PIN(P1); PKH(_w0, P0, 8); \
    EXP2E(P1, 10); PIN(P1); PKH(_w1, P0, 10); \
    EXP2E(P1, 12); PIN(P1); PKH(_w2, P0, 12); \
    EXP2E(P1, 14); PIN(P1); PKH(_w3, P0, 14); { u32x4 _w = {_w0, _w1, _w2, _w3}; pa1 = *reinterpret_cast<bf16x8*>(&_w); PIN(pa1); } \
    LOADG(fa, 0, VBN); LOADG(fb, 1, VBN); } while (0)
#define H2LAST(VB, P0, P1) do { const int _vb = (VB); unsigned _w0, _w1, _w2, _w3; float _s0 = 0.f, _s1 = 0.f; \
    PIN(P1); \
    WAITL(8, fa); \
    PVM(0, pa0, fa0l, fa0h); SUM2(0, P0, P1); PKH(_w0, P1, 0); \
    PVM(1, pa0, fa1l, fa1h); SUM2(1, P0, P1); PKH(_w1, P1, 2); \
    PVM(2, pa0, fa2l, fa2h); SUM2(2, P0, P1); PKH(_w2, P1, 4); \
    PVM(3, pa0, fa3l, fa3h); SUM2(3, P0, P1); PKH(_w3, P1, 6); { u32x4 _w = {_w0, _w1, _w2, _w3}; pa2 = *reinterpret_cast<bf16x8*>(&_w); PIN(pa2); } \
    LOADG(fa, 2, _vb); WAITL(8, fb); \
    PVM(0, pa1, fb0l, fb0h); SUM2(4, P0, P1); PKH(_w0, P1, 8); \
    PVM(1, pa1, fb1l, fb1h); SUM2(5, P0, P1); PKH(_w1, P1, 10); \
    PVM(2, pa1, fb2l, fb2h); SUM2(6, P0, P1); PKH(_w2, P1, 12); \
    PVM(3, pa1, fb3l, fb3h); SUM2(7, P0, P1); PKH(_w3, P1, 14); { u32x4 _w = {_w0, _w1, _w2, _w3}; pa3 = *reinterpret_cast<bf16x8*>(&_w); PIN(pa3); } l_acc += _s0 + _s1; PIN(l_acc); \
    LOADG(fb, 3, _vb); WAITL(8, fa); \
    PVM(0, pa2, fa0l, fa0h); \
    PVM(1, pa2, fa1l, fa1h); \
    PVM(2, pa2, fa2l, fa2h); \
    PVM(3, pa2, fa3l, fa3h); \
    WAITL(0, fb); \
    PVM(0, pa3, fb0l, fb0h); \
    PVM(1, pa3, fb1l, fb1h); \
    PVM(2, pa3, fb2l, fb2h); \
    PVM(3, pa3, fb3l, fb3h); } while (0)
    if (mm == 1) __builtin_amdgcn_s_setprio(1);
    RBAR();
#define CLAMPT(x) ((x) < NT ? (x) : NT - 1)
    for (int t = 0; t + 2 < NT; t += 2) {
        const int b0 = BOFF(t), b1 = BOFF(t + 1), b2 = BOFF(t + 2);
        s16x4 fa0l, fa0h, fa1l, fa1h, fa2l, fa2h, fa3l, fa3h, fb0l, fb0h, fb1l, fb1h, fb2l, fb2h, fb3l, fb3h;
        DMAK2(CLAMPT(t + 3), t + 3); DMAV2(CLAMPT(t + 2), t + 2); DMAK2(CLAMPT(t + 4), t + 4); DMAV2(CLAMPT(t + 3), t + 3);
        H1STEP(pA0, pA1, pB0, pB1, b1, vb0 + b0);
        H2STEP(vb0 + b0, pA0, pA1, pB0);
        H1STEP(pB0, pB1, pA0, pA1, b2, vb0 + b1);
        H2STEP(vb0 + b1, pB0, pB1, pA0);
        asm volatile("s_waitcnt vmcnt(0)" ::: "memory");
        RBAR();
    }
#undef CLAMPT
    {
        const int b0 = BOFF(NT - 2), b1 = BOFF(NT - 1);
        s16x4 fa0l, fa0h, fa1l, fa1h, fa2l, fa2h, fa3l, fa3h, fb0l, fb0h, fb1l, fb1h, fb2l, fb2h, fb3l, fb3h;
        H1STEP(pA0, pA1, pB0, pB1, b1, vb0 + b0);
        H2STEP(vb0 + b0, pA0, pA1, pB0);
        H1LAST(pB0, pB1, vb0 + b1);
        H2LAST(vb0 + b1, pB0, pB1);
    }
    asm volatile("s_waitcnt vmcnt(0)" ::: "memory");
    __builtin_amdgcn_s_setprio(0);
#undef PIN
#undef EXP4
#undef KFR
#undef H1STEP
#undef H1LAST
#undef H2LAST
#undef KRD
#undef WAITK
#undef PKN
#undef PKH
#undef EXP2E
#undef SWP
#undef MKPA
#undef QKM
#undef PVM
#undef SUM2
#undef LOADG
#undef PKV
#undef WAITL
#undef H2STEP
    float l_full; { auto rr = __builtin_amdgcn_permlane32_swap(__float_as_uint(l_acc), __float_as_uint(l_acc), false, false); l_full = __uint_as_float(rr[0]) + __uint_as_float(rr[1]); }
    const int bad = !(l_full < 1e30f);
    float* flg = (float*)(lds + 8 * SHM_V) + 512;
    if ((tid_l(wv) & 63) == 0) flg[wid] = __any(bad) ? 1.f : 0.f;
    __syncthreads();
    if (((flg[0] + flg[1]) + (flg[2] + flg[3])) + ((flg[4] + flg[5]) + (flg[6] + flg[7])) > 0.f) { __syncthreads(); attn_unit_exact(Pb, Yb, qrow0, b, h, NT, lamp, subg, lds, wv); return; }
    attn_epilogue(o, l_full, Pb, Yb, qrow0, h, lamp, subg, lds, li_l, wv);
#undef RBAR
#undef KVBASE
#undef DMAV2
#undef DMAK2
#undef BOFF
#undef QKTF
#undef EXPH
#undef PK4
#undef FINF
}
}

__device__ __forceinline__ void light_unit(CParams& p, int l, int ch, int part, char* lds, int wv) {
    const int tid = tid_l(wv), wid = tid >> 6, lane = tid & 63, r32 = lane & 31, hi = lane >> 5;
    const int row0 = ch * 128;
    const bf16_t* Pb = p.P; bf16_t* Yb = p.HY;
    const int rg = wid & 3, hh = wid >> 2, head = part * 2 + hh;
    const int sr_ = tid >> 2, sj = tid & 3;
    bf16x8 v[8];
    { const bf16_t* src = Pb + (size_t)(row0 + sr_) * DIN + COL_AV + sj * 64;
#pragma unroll
      for (int i = 0; i < 8; ++i) v[i] = *reinterpret_cast<const bf16x8*>(src + i * 8); }
    f32x4 gg[16];
    { const float* g = p.sgu_g + l * 256 + sj * 64;
#pragma unroll
      for (int i = 0; i < 16; ++i) gg[i] = *(const f32x4*)(g + i * 4); }
    const int cgp = tid & 15, rr = tid >> 4, cc = part * 128 + cgp * 8;
    const int s0 = row0 < NLAT ? (row0 & ~(SEQ - 1)) : NLAT + ((row0 - NLAT) & ~(CTXL - 1)), s1 = s0 + (row0 < NLAT ? SEQ : CTXL);
    bf16x8 cv[2][4];
#define CONV_LOAD(slot, i) do { const int t = row0 + rr + 32 * (i); const bf16_t* base = Pb + (size_t)t * DIN + cc; \
        cv[slot][0] = *reinterpret_cast<const bf16x8*>(base + COL_CC); cv[slot][1] = *reinterpret_cast<const bf16x8*>(base + COL_CB); \
        cv[slot][2] = (bf16x8){}; cv[slot][3] = (bf16x8){}; \
        if (t - 1 >= s0) cv[slot][2] = *reinterpret_cast<const bf16x8*>(base - DIN + COL_CC); \
        if (t + 1 < s1)  cv[slot][3] = *reinterpret_cast<const bf16x8*>(base + DIN + COL_CC); } while (0)
#define CONV_DO(slot, i) do { const int t = row0 + rr + 32 * (i); float y[8];        \
        _Pragma("unroll") for (int e = 0; e < 8; ++e) y[e] = bf2f(cv[slot][1][e]) * (w0[e] * bf2f(cv[slot][2][e]) + w1[e] * bf2f(cv[slot][0][e]) + w2[e] * bf2f(cv[slot][3][e]) + bb[e]); \
        u32x4 w = {cvtpk(y[0], y[1]), cvtpk(y[2], y[3]), cvtpk(y[4], y[5]), cvtpk(y[6], y[7])}; *(u32x4*)(Yb + (size_t)t * DM + YC + cc) = w; } while (0)
    CONV_LOAD(0, 0);
    float w0[8], w1[8], w2[8], bb[8];
    { const float* cw = p.conv_w + (size_t)l * 3 * 256 + cc; const float* cbv = p.conv_b + l * 256 + cc;
#pragma unroll
      for (int e = 0; e < 8; ++e) { w0[e] = cw[e]; w1[e] = cw[256 + e]; w2[e] = cw[512 + e]; bb[e] = cbv[e]; } }
    {   float ss = 0.f;
#pragma unroll
        for (int i = 0; i < 8; ++i)
#pragma unroll
            for (int e = 0; e < 8; ++e) { const float f = bf2f(v[i][e]); ss += f * f; }
        ss += shx(ss, lane, 1); ss += shx(ss, lane, 2);
        const float rstd = __builtin_amdgcn_rsqf(ss * (1.f / 256.f) + EPS);
        if ((sj >> 1) == part) {
            const int cbase = (sj & 1) * 64;
#pragma unroll
            for (int i = 0; i < 8; ++i) { const f32x4 g0 = gg[2 * i], g1 = gg[2 * i + 1];
                u32x4 w; w.x = cvtpk(bf2f(v[i][0]) * rstd * g0[0], bf2f(v[i][1]) * rstd * g0[1]); w.y = cvtpk(bf2f(v[i][2]) * rstd * g0[2], bf2f(v[i][3]) * rstd * g0[3]);
                w.z = cvtpk(bf2f(v[i][4]) * rstd * g1[0], bf2f(v[i][5]) * rstd * g1[1]); w.w = cvtpk(bf2f(v[i][6]) * rstd * g1[2], bf2f(v[i][7]) * rstd * g1[3]);
                *(u32x4*)(lds + (sr_ >> 6) * at::SHM_V + at::v_st(sr_ & 63, cbase + i * 8)) = w; }
        }
    }
    f32x4 wa[2][4], wb[2][4];
    { const float* W = p.sgu_w + ((size_t)(l * 4 + head) * 128 + rg * 32 + r32) * 128 + hi * 8;
#pragma unroll
      for (int tile = 0; tile < 2; ++tile)
#pragma unroll
          for (int ks = 0; ks < 4; ++ks) { wa[tile][ks] = *(const f32x4*)(W + tile * 64 + ks * 16); wb[tile][ks] = *(const f32x4*)(W + tile * 64 + ks * 16 + 4); } }
    bf16x8 gu[4];
#pragma unroll
    for (int jj = 0; jj < 4; ++jj) { const int c = tid + 512 * jj, row = c >> 4, col8 = (c & 15) * 8;
        gu[jj] = *reinterpret_cast<const bf16x8*>(Pb + (size_t)(row0 + row) * DIN + COL_AU + part * 128 + col8); }
    __syncthreads();
    CONV_DO(0, 0); CONV_LOAD(1, 1);
    {
        f32x16 o0 = {}, o1 = {};
        const int vb0 = (int)(uintptr_t)lds + at::v_rd_base(lane);
#pragma unroll
        for (int tile = 0; tile < 2; ++tile) {
            bf16x8 pa[4];
#pragma unroll
            for (int ks = 0; ks < 4; ++ks) { const f32x4 a = wa[tile][ks], bq = wb[tile][ks];
                u32x4 w = {cvtpk(a[0], a[1]), cvtpk(a[2], a[3]), cvtpk(bq[0], bq[1]), cvtpk(bq[2], bq[3])}; pa[ks] = *reinterpret_cast<bf16x8*>(&w); }
            if (hh == 0) { at::pv_one<0>(o0, vb0 + tile * at::SHM_V, pa[0], pa[1], pa[2], pa[3]); at::pv_one<1>(o1, vb0 + tile * at::SHM_V, pa[0], pa[1], pa[2], pa[3]); }
            else         { at::pv_one<2>(o0, vb0 + tile * at::SHM_V, pa[0], pa[1], pa[2], pa[3]); at::pv_one<3>(o1, vb0 + tile * at::SHM_V, pa[0], pa[1], pa[2], pa[3]); }
        }
        const float* bs = p.sgu_b + (size_t)(l * 4 + head) * 128 + rg * 32;
        float* mx = (float*)(lds + 2 * at::SHM_V) + ((hh * 4 + rg) * 2) * 1024 + lane;
#pragma unroll
        for (int q = 0; q < 4; ++q) { const f32x4 b4 = *(const f32x4*)(bs + 8 * q + 4 * hi);
#pragma unroll
            for (int j = 0; j < 4; ++j) { const int r = 4 * q + j; mx[r * 64] = o0[r] + b4[j]; mx[1024 + r * 64] = o1[r] + b4[j]; } }
    }
    __syncthreads();
    CONV_DO(1, 1); CONV_LOAD(0, 2);
    {
        const float* mbase = (const float*)(lds + 2 * at::SHM_V);
#pragma unroll
        for (int jj = 0; jj < 4; ++jj) { const int c = tid + 512 * jj, row = c >> 4, col8 = (c & 15) * 8;
            const int hq = col8 >> 6, d = col8 & 63, dd = d >> 5, rb = d & 31, rgq = row >> 5, within = row & 31, hiq = (within >> 2) & 1, r = (within & 3) + 4 * (within >> 3);
            const float* mp = mbase + (((hq * 4 + rgq) * 2 + dd) * 16 + r) * 64 + hiq * 32 + rb;
            const f32x4 m0 = *(const f32x4*)mp, m1 = *(const f32x4*)(mp + 4);
            u32x4 w = {cvtpk(m0[0] * bf2f(gu[jj][0]), m0[1] * bf2f(gu[jj][1])), cvtpk(m0[2] * bf2f(gu[jj][2]), m0[3] * bf2f(gu[jj][3])),
                       cvtpk(m1[0] * bf2f(gu[jj][4]), m1[1] * bf2f(gu[jj][5])), cvtpk(m1[2] * bf2f(gu[jj][6]), m1[3] * bf2f(gu[jj][7]))};
            *(u32x4*)(Yb + (size_t)(row0 + row) * DM + YA + part * 128 + col8) = w; }
    }
    CONV_DO(0, 2); CONV_LOAD(1, 3);
    CONV_DO(1, 3);
#undef CONV_LOAD
#undef CONV_DO
    __syncthreads();
}

__device__ __forceinline__ void sincos_f(float a, float& s, float& c) {
    const float k = rintf(a * 0.636619772f);
    float r = fmaf(-k, 1.5707962513e+00f, a); r = fmaf(-k, 7.5497894159e-08f, r); r = fmaf(-k, 5.3903029534e-15f, r);
    const float r2 = r * r;
    float sp = 2.7557319224e-6f; sp = fmaf(sp, r2, -1.9841269841e-4f); sp = fmaf(sp, r2, 8.3333333333e-3f); sp = fmaf(sp, r2, -1.6666666667e-1f); const float sr = fmaf(r * r2, sp, r);
    float cp = 2.4801587302e-5f; cp = fmaf(cp, r2, -1.3888888889e-3f); cp = fmaf(cp, r2, 4.1666666667e-2f); cp = fmaf(cp, r2, -0.5f); const float cr = fmaf(r2, cp, 1.0f);
    const int q = ((int)k) & 3;
    s = (q == 0) ? sr : (q == 1) ? cr : (q == 2) ? -sr : -cr;
    c = (q == 0) ? cr : (q == 1) ? -sr : (q == 2) ? -cr : sr;
}

__device__ __forceinline__ void convert_weights(CParams& p, int l, int first, int stride, char* lds, int wv) {
    const int tid = tid_l(wv);
    float* T = (float*)lds;
    const float* srcI = p.w_in + (size_t)l * DM * DIN; bf16_t* dstI = p.WinT + (size_t)l * DIN * DM;
    const float* srcO = p.w_out + (size_t)l * DM * DM; bf16_t* dstO = p.WoutT + (size_t)l * DM * DM;
    for (int u0 = first; u0 < 1216; u0 += 4 * stride) {
        f32x4 va[4], vb[4]; bf16_t* dq[4];
#pragma unroll
        for (int q = 0; q < 4; ++q) { const int u = u0 + q * stride; va[q] = (f32x4){0.f, 0.f, 0.f, 0.f}; vb[q] = va[q]; dq[q] = nullptr;
            if (u < 1216) { const float* src; bf16_t* dst; int N, kt, nt;
                int ntd;
                if (u < 960) { kt = u / 60; nt = u % 60; src = srcI; dst = dstI; N = DIN;
                    const int blk = nt >> 1, nb = blk == 1 ? 4 : blk == 4 ? 1 : blk == 23 ? 28 : blk == 28 ? 23 : blk == 25 ? 26 : blk == 26 ? 25 : blk; ntd = nb * 2 + (nt & 1); }
                else { const int v = u - 960; kt = v / 16; nt = v % 16; src = srcO; dst = dstO; N = DM; ntd = nt; }
                const int row = tid >> 3, cs = (tid & 7) * 8; const float* sp = src + (size_t)(kt * 64 + row) * N + nt * 64 + cs;
                va[q] = *(const f32x4*)sp; vb[q] = *(const f32x4*)(sp + 4);
                dq[q] = dst + (size_t)(ntd * 64 + (tid >> 3)) * DM + kt * 64 + (tid & 7) * 8; } }
#pragma unroll
        for (int q = 0; q < 4; ++q) { const int row = tid >> 3, cs = (tid & 7) * 8; float* t = T + q * 4160 + row * 65 + cs;
            t[0] = va[q][0]; t[1] = va[q][1]; t[2] = va[q][2]; t[3] = va[q][3]; t[4] = vb[q][0]; t[5] = vb[q][1]; t[6] = vb[q][2]; t[7] = vb[q][3]; }
        __syncthreads();
#pragma unroll
        for (int q = 0; q < 4; ++q) { const int n = tid >> 3, kc = (tid & 7) * 8; const float* t = T + q * 4160 + kc * 65 + n;
            if (dq[q]) { u32x4 w = {cvtpk(t[0], t[65]), cvtpk(t[130], t[195]), cvtpk(t[260], t[325]), cvtpk(t[390], t[455])}; *(u32x4*)dq[q] = w; } }
        __syncthreads();
    }
}

__device__ __forceinline__ void phase_prep(CParams& p, char* lds, int wv) {
    const int tid = tid_l(wv), bid = bid_l();
    float* S = (float*)(lds + 4 * 16640);
    float* R = (float*)(lds + 4 * 16640 + 12288);
    convert_weights(p, 0, bid, (int)gridDim.x, lds, wv);
    if (bid < 192) {
        for (int i = tid; i < 3072; i += 512) { const int cnd = i >> 10, k = i & 1023; const float v = cnd < 2 ? p.c[cnd * 1024 + k] : p.c_ctx[k]; S[i] = v / (1.f + expf(-v)); }
        __syncthreads();
        for (int u = bid; u < 192; u += gridDim.x) {
            const int l = u / 48, c0 = (u % 48) * 64, j4 = (tid & 15) * 4, kg = tid >> 4;
            const float* w = p.w_mod + (size_t)l * DM * 3072 + c0 + j4;
            f32x4 a0 = {0.f, 0.f, 0.f, 0.f}, a1 = a0, a2 = a0;
#pragma unroll 8
            for (int k = kg; k < 1024; k += 32) { const f32x4 wv4 = *(const f32x4*)(w + (size_t)k * 3072); a0 += wv4 * S[k]; a1 += wv4 * S[1024 + k]; a2 += wv4 * S[2048 + k]; }
            *(f32x4*)(R + (0 * 32 + kg) * 64 + j4) = a0; *(f32x4*)(R + (1 * 32 + kg) * 64 + j4) = a1; *(f32x4*)(R + (2 * 32 + kg) * 64 + j4) = a2;
            __syncthreads();
            if (tid < 192) { const int cnd = tid >> 6, jj = tid & 63; float sm = 0.f;
#pragma unroll
                for (int g = 0; g < 32; ++g) sm += R[(cnd * 32 + g) * 64 + jj];
                p.mod[(size_t)(l * 3 + cnd) * 3072 + c0 + jj] = sm + p.b_mod[l * 3072 + c0 + jj]; }
            __syncthreads();
        }
    }
    if (bid == (int)gridDim.x - 1) {
        for (int i = tid; i < 2048; i += 512) { const int pos = i >> 4, pp = i & 15;
            const float inv = __builtin_amdgcn_exp2f(-(float)pp * 0.830482023721841f);
            float s, c; sincos_f((float)pos * inv, s, c); p.rope[i] = c; p.rope[2048 + i] = s; }
        if (tid < DEPTH) { float d1 = 0.f, d2 = 0.f;
            for (int k = 0; k < 64; ++k) { d1 += p.lq1[tid * 64 + k] * p.lk1[tid * 64 + k]; d2 += p.lq2[tid * 64 + k] * p.lk2[tid * 64 + k]; }
            const float li = 0.8f - 0.6f * expf(-0.3f * (float)tid); p.lam[tid] = expf(d1) - expf(d2) + li; p.lam[DEPTH + tid] = 1.f - li; }
    }
}

__device__ __forceinline__ float wave_sum(float v, int lane) {
    v = row16_sum(v); v += shx(v, lane, 16); v += shx(v, lane, 32); return v;
}
__device__ __forceinline__ void phase_norm(CParams& p, int l, int wv) {
    const int tid = tid_l(wv), wid = tid >> 6, lane = tid & 63, bid = bid_l();
    const float* modl = p.mod + (size_t)l * 3 * 3072; const float* g = p.norm_g + l * DM;
    f32x4 ga[4], sb[4]; int cur = -1;
    const int stride = (int)gridDim.x * 8;
    f32x4 v[4], vn[4];
#define XROW(r) ((l == 0) ? ((r) < NLAT ? p.x + (size_t)(r) * DM : p.ctx + (size_t)((r) - NLAT) * DM) : ((r) < NLAT ? p.xlat + (size_t)(r) * DM : p.xctx + (size_t)((r) - NLAT) * DM))
    int row = bid * 8 + wid;
    if (row < NROW) { const float* xr = XROW(row);
#pragma unroll
        for (int i = 0; i < 4; ++i) v[i] = *(const f32x4*)(xr + i * 256 + lane * 4); }
    for (; row < NROW; row += stride) {
        const int nrow = row + stride;
        if (nrow < NROW) { const float* xr = XROW(nrow);
#pragma unroll
            for (int i = 0; i < 4; ++i) vn[i] = *(const f32x4*)(xr + i * 256 + lane * 4); }
        const int cnd = row < SEQ ? 0 : row < NLAT ? 1 : 2;
        float ss = 0.f;
#pragma unroll
        for (int i = 0; i < 4; ++i) ss += v[i][0] * v[i][0] + v[i][1] * v[i][1] + v[i][2] * v[i][2] + v[i][3] * v[i][3];
        if (cnd != cur) { cur = cnd; const float* sh = modl + cnd * 3072; const float* sc = sh + 1024;
#pragma unroll
            for (int i = 0; i < 4; ++i) { const int col = i * 256 + lane * 4; ga[i] = *(const f32x4*)(g + col) * (*(const f32x4*)(sc + col) + 1.f); sb[i] = *(const f32x4*)(sh + col); } }
        ss = wave_sum(ss, lane); const float rstd = __builtin_amdgcn_rsqf(ss * (1.f / 1024.f) + EPS);
#pragma unroll
        for (int i = 0; i < 4; ++i) { const int col = i * 256 + lane * 4;
            const f32x4 o = v[i] * rstd * ga[i] + sb[i];
            u32x2 w = {cvtpk(o[0], o[1]), cvtpk(o[2], o[3])}; *(u32x2*)(p.HY + (size_t)row * DM + col) = w; }
#pragma unroll
        for (int i = 0; i < 4; ++i) v[i] = vn[i];
    }
#undef XROW
}
__device__ __forceinline__ void phase_final(CParams& p, int wv) {
    const int tid = tid_l(wv), wid = tid >> 6, lane = tid & 63, bid = bid_l();
    f32x4 fg[4];
#pragma unroll
    for (int i = 0; i < 4; ++i) fg[i] = *(const f32x4*)(p.final_g + i * 256 + lane * 4);
    const int stride = (int)gridDim.x * 8;
    f32x4 v[4], vn[4];
    int row = bid * 8 + wid;
    if (row < NLAT) { const float* xr = p.xlat + (size_t)row * DM;
#pragma unroll
        for (int i = 0; i < 4; ++i) v[i] = *(const f32x4*)(xr + i * 256 + lane * 4); }
    for (; row < NLAT; row += stride) {
        const int nrow = row + stride;
        if (nrow < NLAT) { const float* xr = p.xlat + (size_t)nrow * DM;
#pragma unroll
            for (int i = 0; i < 4; ++i) vn[i] = *(const f32x4*)(xr + i * 256 + lane * 4); }
        float* xw = p.xlat + (size_t)row * DM;
        float ss = 0.f;
#pragma unroll
        for (int i = 0; i < 4; ++i) ss += v[i][0] * v[i][0] + v[i][1] * v[i][1] + v[i][2] * v[i][2] + v[i][3] * v[i][3];
        ss = wave_sum(ss, lane); const float rstd = __builtin_amdgcn_rsqf(ss * (1.f / 1024.f) + EPS);
#pragma unroll
        for (int i = 0; i < 4; ++i) { const int col = i * 256 + lane * 4; *(f32x4*)(xw + col) = v[i] * rstd * fg[i]; }
#pragma unroll
        for (int i = 0; i < 4; ++i) v[i] = vn[i];
    }
}

__device__ __forceinline__ void phase_mix(CParams& p, int l, char* lds, int wv) {
    const int c = bid_l(), G = gridDim.x;
    const float* subg = p.subln_g + l * 128;
    const int nlat_u = (512 - c + G - 1) / G;
    for (int k = 0; k <= nlat_u; ++k) {
        int qrow0, b, h, NT;
        if (k < nlat_u) { const int u = c + k * G, bh = u & 7, qb = u >> 3; b = bh >> 2; h = bh & 3; qrow0 = b * SEQ + qb * 128; NT = 132; }
        else { const int u = (c + G - 16) % G; if (l == DEPTH - 1 || u >= 16) break; const int bh = u & 7, qb = u >> 3; b = bh >> 2; h = bh & 3; qrow0 = NLAT + b * CTXL + qb * 128; NT = 4; }
        at::attn_unit(p.P, p.HY, qrow0, b, h, NT, p.lam + l, subg, lds, (PG8_LAS unsigned char*)lds, wv);
    }
    const int nlight = (l < DEPTH - 1 ? NROW / 128 : NLAT / 128) * 2;
    const bool give = (l < DEPTH - 1) && G >= 48;
    int u = c; bool extra_done = false;
    for (;;) {
        int uu;
        if (u < nlight) { uu = u; u += G; if (give && uu >= 16 && uu < 32) continue; }
        else if (!extra_done) { extra_done = true; if (!(give && c >= 32 && c < 48)) break; uu = c - 16; }
        else break;
        light_unit(p, l, uu >> 1, uu & 1, lds, wv);
    }
}

__device__ __forceinline__ void ctx_outproj(CParams& p, int l, char* lds, int wv) {
    const int tid = tid_l(wv), wid = tid >> 6, lane = tid & 63, r32 = lane & 31, hi = lane >> 5;
    const float* xsrc = l == 0 ? p.ctx : p.xctx; const float* gate = p.mod + (size_t)(l * 3 + 2) * 3072 + 2048;
    float* part = (float*)lds;
    for (int u = bid_l(); u < 256; u += gridDim.x) {
        const int row0 = (u >> 4) * 32, col0 = (u & 15) * 64;
        const bf16_t* A = p.HY + (size_t)(NLAT + row0 + r32) * DM + wid * 128 + hi * 8;
        const bf16_t* B = p.WoutT + (size_t)l * DM * DM + (size_t)(col0 + r32) * DM + wid * 128 + hi * 8;
        f32x16 acc0 = {}, acc1 = {};
#pragma unroll
        for (int ks = 0; ks < 8; ++ks) {
            const bf16x8 a = *reinterpret_cast<const bf16x8*>(A + ks * 16), b0 = *reinterpret_cast<const bf16x8*>(B + ks * 16), b1 = *reinterpret_cast<const bf16x8*>(B + 32 * DM + ks * 16);
            acc0 = __builtin_amdgcn_mfma_f32_32x32x16_bf16(a, b0, acc0, 0, 0, 0); acc1 = __builtin_amdgcn_mfma_f32_32x32x16_bf16(a, b1, acc1, 0, 0, 0); }
#pragma unroll
        for (int r = 0; r < 16; ++r) { part[wid * 2048 + r * 64 + lane] = acc0[r]; part[wid * 2048 + 1024 + r * 64 + lane] = acc1[r]; }
        __syncthreads();
        float xs4[4], gt4[4];
#pragma unroll
        for (int j = 0; j < 4; ++j) { const int e = tid + 512 * j, cb = e >> 10, r = (e >> 6) & 15, ln = e & 63, row = row0 + at::crow(r, ln >> 5), col = col0 + cb * 32 + (ln & 31);
            xs4[j] = xsrc[(size_t)row * DM + col]; gt4[j] = gate[col]; }
#pragma unroll
        for (int j = 0; j < 4; ++j) { const int e = tid + 512 * j; float sum = 0.f;
#pragma unroll
            for (int w = 0; w < 8; ++w) sum += part[w * 2048 + e];
            const int cb = e >> 10, r = (e >> 6) & 15, ln = e & 63, row = row0 + at::crow(r, ln >> 5), col = col0 + cb * 32 + (ln & 31);
            p.xctx[(size_t)row * DM + col] = xs4[j] + gt4[j] * sum; }
        __syncthreads();
    }
}

#define XB_TMO      128
#define XB_XCNT(j)  (256  + 64 * (j))
#define XB_XSUB(j)  (1280 + 64 * (j))
#define XB_XGEN(j)  (2304 + 64 * (j))
#define XB_TOP      3328
#define XB_TOPGEN   3392
#define XB_WORDS    3456
#define XB_SPIN_CAP (1u << 18)
__device__ __forceinline__ unsigned xb_ld(unsigned* p)              { return __hip_atomic_load(p, __ATOMIC_RELAXED, __HIP_MEMORY_SCOPE_AGENT); }
__device__ __forceinline__ unsigned xb_add(unsigned* p, unsigned v) { return __hip_atomic_fetch_add(p, v, __ATOMIC_RELAXED, __HIP_MEMORY_SCOPE_AGENT); }
__device__ __forceinline__ unsigned xb_xcc_id() { return (unsigned)__builtin_amdgcn_s_getreg((3 << 11) | 20) & 0xFu; }
#define XB_SPIN(cond, bar) do { unsigned _sp = 0; while (cond) { __builtin_amdgcn_s_sleep(1); \
    if ((++_sp & 255u) == 0u) { if (xb_ld(&(bar)[XB_TMO])) break; if (_sp > XB_SPIN_CAP) { atomicAdd(&(bar)[XB_TMO], 1u); break; } } } } while (0)
__device__ __forceinline__ void xb_complete(unsigned* bar, unsigned x, unsigned& nloc, unsigned& nx) {
    const unsigned G = gridDim.x;
    unsigned sum, cnt, mine, sp = 0u;
    for (;;) {
        sum = 0u; cnt = 0u; mine = 0u;
#pragma unroll
        for (unsigned j = 0; j < 16; ++j) { const unsigned c = xb_ld(&bar[XB_XCNT(j)]); sum += c; cnt += (c > 0u) ? 1u : 0u; mine = (j == x) ? c : mine; }
        if (sum == G) break;
        __builtin_amdgcn_s_sleep(1);
        if ((++sp & 255u) == 0u) { if (xb_ld(&bar[XB_TMO])) break; if (sp > XB_SPIN_CAP) { atomicAdd(&bar[XB_TMO], 1u); break; } }
    }
    nloc = mine > 0u ? mine : 1u; nx = cnt > 0u ? cnt : 1u;
}
__device__ __forceinline__ void grid_bar(unsigned* bar, volatile PG8_LAS unsigned* st, int wv) {
    asm volatile("s_waitcnt vmcnt(0)" ::: "memory");
    __syncthreads();
    if (tid_l(wv) == 0) {
        __builtin_amdgcn_s_waitcnt(0);
        const unsigned x = xb_xcc_id();
        unsigned nloc = st[0], nx = st[1];
        if (nloc == 0u) { xb_complete(bar, x, nloc, nx); st[0] = nloc; st[1] = nx; }
        const unsigned old = xb_add(&bar[XB_XSUB(x)], 1u);
        const unsigned gen = old / nloc;
        if (old + 1u == (gen + 1u) * nloc) {
            __builtin_amdgcn_fence(__ATOMIC_RELEASE, "agent");
            asm volatile("s_waitcnt vmcnt(0)" ::: "memory");
            const unsigned og = xb_add(&bar[XB_TOP], 1u);
            const unsigned tg = og / nx;
            if (og + 1u == (tg + 1u) * nx) xb_add(&bar[XB_TOPGEN], 1u);
            else XB_SPIN(xb_ld(&bar[XB_TOPGEN]) == tg, bar);
            __builtin_amdgcn_fence(__ATOMIC_ACQUIRE, "agent");
            xb_add(&bar[XB_XGEN(x)], 1u);
            asm volatile("s_waitcnt vmcnt(0)" ::: "memory");
        } else {
            XB_SPIN(xb_ld(&bar[XB_XGEN(x)]) == gen, bar);
            __builtin_amdgcn_fence(__ATOMIC_ACQUIRE, "agent");
            asm volatile("s_waitcnt vmcnt(0)" ::: "memory");
        }
    }
    __syncthreads();
}

__global__ __launch_bounds__(512, 2) void mega(Params p_unused) {
    extern __shared__ __attribute__((aligned(16))) unsigned char shm[];
    const int wv = __builtin_amdgcn_readfirstlane((int)(threadIdx.x >> 6));
    volatile PG8_LAS unsigned* xst = (volatile PG8_LAS unsigned*)((PG8_LAS unsigned char*)shm + 131072 + 2048 + 64);
    {
        CParams& p = params_l();
        if (tid_l(wv) == 0) { xst[0] = 0u; xst[1] = 0u; (void)xb_add(&p.bar[XB_XCNT(xb_xcc_id())], 1u); }
        phase_prep(p, (char*)shm, wv);
        if (gridDim.x == 0x7fffffffu) cg::this_grid().sync();
        grid_bar(p.bar, xst, wv);
    }
#pragma clang loop unroll(disable)
    for (int l = 0; l < DEPTH; ++l) {
        { CParams& p = params_l(); phase_norm(p, l, wv); grid_bar(p.bar, xst, wv); }
        { CParams& p = params_l();
          pg8::Gemm g{p.HY, p.WinT + (size_t)l * DIN * DM, NROW, DIN, DM};
          pg8::StaticOrder S; S.init(g.M, g.N, (int)gridDim.x, bid_l());
          EpiIn E{p.P, p.rope};
          pg8::gemm_phase<EpiIn, pg8::StaticOrder>((PG8_LAS unsigned char*)shm, g, S, E, wv);
          if (l < DEPTH - 1) {
              const int Gi = (int)gridDim.x, nwg = (NROW / 256) * (DIN / 256), maxu = (nwg + Gi - 1) / Gi, nidle = Gi * maxu - nwg, c = bid_l();
              if (nidle == 0) convert_weights(p, l + 1, c, Gi, (char*)shm, wv);
              else if (c >= Gi - nidle) convert_weights(p, l + 1, c - (Gi - nidle), nidle, (char*)shm, wv);
          }
          grid_bar(p.bar, xst, wv); }
        { CParams& p = params_l(); phase_mix(p, l, (char*)shm, wv); grid_bar(p.bar, xst, wv); }
        { CParams& p = params_l();
          pg8::Gemm g{p.HY, p.WoutT + (size_t)l * DM * DM, NLAT, DM, DM};
          pg8::StaticOrder S; S.init(g.M, g.N, (int)gridDim.x, bid_l());
          EpiOut E{l == 0 ? p.x : p.xlat, l == 0 ? p.ctx : p.xctx, p.xlat, p.xctx, p.mod + (size_t)l * 3 * 3072};
          pg8::gemm_phase<EpiOut, pg8::StaticOrder>((PG8_LAS unsigned char*)shm, g, S, E, wv);
          if (l < DEPTH - 1) ctx_outproj(p, l, (char*)shm, wv);
          grid_bar(p.bar, xst, wv); }
    }
    { CParams& p = params_l(); phase_final(p, wv); }
}

constexpr size_t LDS_BYTES = 131072 + 2048 + 128;
static inline size_t al256(size_t x) { return (x + 255) / 256 * 256; }
extern "C" void kernel_launch(void* const* d_in, const int* in_sizes, int n_in, void* d_out, int out_size, void* d_ws, size_t ws_size, hipStream_t stream) {
    static int grid_blocks = 0;
    if (!grid_blocks) {
        int dev = 0, cus = 0, per_cu = 0;
        hipGetDevice(&dev);
        hipDeviceGetAttribute(&cus, hipDeviceAttributeMultiprocessorCount, dev);
        if (hipFuncSetAttribute((const void*)mega, hipFuncAttributeMaxDynamicSharedMemorySize, (int)LDS_BYTES) != hipSuccess) fprintf(stderr, "kernel_launch: hipFuncSetAttribute failed\n");
        hipOccupancyMaxActiveBlocksPerMultiprocessor(&per_cu, mega, 512, LDS_BYTES);
        if (per_cu < 1) per_cu = 1;
        if (cus < 1) cus = 256;
        grid_blocks = cus * (per_cu > 1 ? 1 : per_cu);
    }
    Params p{};
    p.x = (const float*)d_in[0]; p.c = (const float*)d_in[1]; p.ctx = (const float*)d_in[2]; p.c_ctx = (const float*)d_in[3]; p.w_mod = (const float*)d_in[4]; p.b_mod = (const float*)d_in[5];
    p.norm_g = (const float*)d_in[6]; p.w_in = (const float*)d_in[7]; p.w_out = (const float*)d_in[8]; p.sgu_g = (const float*)d_in[9]; p.sgu_w = (const float*)d_in[10]; p.sgu_b = (const float*)d_in[11];
    p.lq1 = (const float*)d_in[12]; p.lk1 = (const float*)d_in[13]; p.lq2 = (const float*)d_in[14]; p.lk2 = (const float*)d_in[15]; p.subln_g = (const float*)d_in[16];
    p.conv_w = (const float*)d_in[17]; p.conv_b = (const float*)d_in[18]; p.final_g = (const float*)d_in[19];
    char* w = (char*)d_ws; size_t off = 0;
    p.xlat = (float*)d_out;
    p.xctx = (float*)(w + off); off += al256((size_t)NCTX * DM * 4);
    p.WinT = (bf16_t*)(w + off); off += al256((size_t)DEPTH * DIN * DM * 2);
    p.WoutT = (bf16_t*)(w + off); off += al256((size_t)DEPTH * DM * DM * 2);
    p.mod = (float*)(w + off); off += al256((size_t)DEPTH * 3 * 3072 * 4);
    p.rope = (float*)(w + off); off += al256(4096 * 4);
    p.lam = (float*)(w + off); off += 256;
    p.bar = (unsigned*)(w + off); off += al256(XB_WORDS * 4);
    p.HY = (bf16_t*)(w + off); off += al256((size_t)NROW * DM * 2);
    p.P = (bf16_t*)(w + off); off += al256((size_t)NROW * DIN * 2);
    if (off > ws_size) { fprintf(stderr, "kernel_launch: workspace too small: need %zu have %zu\n", off, ws_size); return; }
    if (hipMemsetAsync(p.bar, 0, XB_WORDS * 4, stream) != hipSuccess) fprintf(stderr, "kernel_launch: hipMemsetAsync failed\n");
    void* args[] = {&p};
    hipError_t e = hipLaunchCooperativeKernel((const void*)mega, dim3(grid_blocks), dim3(512), args, LDS_BYTES, stream);
    if (e != hipSuccess) fprintf(stderr, "kernel_launch: cooperative launch failed: %s (grid %d)\n", hipGetErrorString(e), grid_blocks);
}
```

```cpp
#include <hip/hip_runtime.h>
#include <hip/hip_cooperative_groups.h>
#include <cstdio>
#include <cmath>
namespace cg = cooperative_groups;


constexpr int DM = 1024, NBATCH = 2, SEQ = 8192, DEPTH = 4, CTXL = 256;
constexpr int NLAT = NBATCH * SEQ, NCTX = NBATCH * CTXL, NROW = NLAT + NCTX;
constexpr int DIN = 3840;
constexpr int COL_AU = 0, COL_AV = 256, COL_AZ = 512, COL_Q = 768, COL_K = 1280, COL_V = 1792, COL_BZ = 2304, COL_CB = 2816, COL_CC = 3072, COL_CX = 3328, COL_CZ = 3584;
constexpr int YA = 0, YB = 256, YC = 768;
constexpr float EPS = 1e-6f;
constexpr int NPHASE = 2 + 4 * DEPTH;

typedef unsigned short bf16_t;
typedef short bf16x8 __attribute__((ext_vector_type(8)));
typedef short s16x4 __attribute__((ext_vector_type(4)));
typedef float f32x4 __attribute__((ext_vector_type(4)));
typedef float f32x16 __attribute__((ext_vector_type(16)));
typedef unsigned u32x4 __attribute__((ext_vector_type(4)));
typedef unsigned u32x2 __attribute__((ext_vector_type(2)));

struct Params {
    const float* x; const float* c; const float* ctx; const float* c_ctx; const float* w_mod; const float* b_mod; const float* norm_g;
    const float* w_in; const float* w_out; const float* sgu_g; const float* sgu_w; const float* sgu_b;
    const float* lq1; const float* lk1; const float* lq2; const float* lk2; const float* subln_g; const float* conv_w; const float* conv_b; const float* final_g;
    float* xlat;
    float* xctx;
    bf16_t* WinT;
    bf16_t* WoutT;
    float* mod;
    float* rope;
    float* lam;
    unsigned* bar;
    bf16_t* HY;
    bf16_t* P;
};

typedef const __attribute__((address_space(4))) Params CParams;
__device__ __forceinline__ CParams& params_l() { unsigned long long k = (unsigned long long)__builtin_amdgcn_kernarg_segment_ptr(); asm volatile("" : "+s"(k)); return *(CParams*)k; }
__device__ __forceinline__ int tid_l(int wv) { int t; asm volatile("v_mbcnt_lo_u32_b32 %0, -1, 0\n\tv_mbcnt_hi_u32_b32 %0, -1, %0\n\tv_lshl_or_b32 %0, %1, 6, %0" : "=&v"(t) : "s"(wv)); return t; }
__device__ __forceinline__ int bid_l() { int t = blockIdx.x; asm volatile("" : "+s"(t)); return t; }
__device__ __forceinline__ float shx(float v, int lane, int m) { return __int_as_float(__builtin_amdgcn_ds_bpermute((lane ^ m) << 2, __float_as_int(v))); }
#define DPP_ADD(v, CTRL) ((v) + __int_as_float(__builtin_amdgcn_update_dpp(0, __float_as_int(v), (CTRL), 0xf, 0xf, false)))
__device__ __forceinline__ float row16_sum(float v) { v = DPP_ADD(v, 0xB1); v = DPP_ADD(v, 0x4E); v = DPP_ADD(v, 0x141); v = DPP_ADD(v, 0x140); return v; }
__device__ __forceinline__ float swap32(float v, int hi) { auto rr = __builtin_amdgcn_permlane32_swap(__float_as_uint(v), __float_as_uint(v), false, false); return __uint_as_float(hi ? rr[0] : rr[1]); }
__device__ __forceinline__ float bf2f(short s) { return __uint_as_float(((unsigned)(unsigned short)s) << 16); }
__device__ __forceinline__ unsigned cvtpk(float lo, float hi) { unsigned r; asm volatile("v_cvt_pk_bf16_f32 %0, %1, %2" : "=v"(r) : "v"(lo), "v"(hi)); return r; }
__device__ __forceinline__ float silu_f(float x) { return x * __builtin_amdgcn_rcpf(1.f + __builtin_amdgcn_exp2f(-1.4426950408889634f * x)); }
__device__ __forceinline__ float gelu_f(float x) { const float z = x * (1.f + 0.044715f * x * x); return x * __builtin_amdgcn_rcpf(1.f + __builtin_amdgcn_exp2f(-2.3022081985f * z)); }

namespace pg8 {
#define PG8_LAS __attribute__((address_space(3)))
constexpr int BM = 256, BK = 64, HALF = 128, HTB = HALF * BK * 2, STAGE_BYTES = 8 * HTB, NXCD = 8, WGM = 8;
__device__ __forceinline__ int lds_byte(int r, int c) { const int st = (r >> 4) * 2 + (c >> 5), rr = r & 15, cc = c & 31, ob = rr * 64 + cc * 2; return st * 1024 + (ob ^ (((ob >> 9) & 1) << 5)); }
__device__ __forceinline__ void stage_rc(int b, int& R, int& C) { const int st = b / 1024, sb = b % 1024, swz = sb ^ (((sb >> 9) & 1) << 5); R = (st >> 1) * 16 + swz / 64; C = (st & 1) * 32 + (swz % 64) / 2; }
__device__ __forceinline__ int perm32(int rho) { const int n = rho >> 4, i = rho & 15; return 8 * (i >> 2) + 4 * n + (i & 3); }
struct Unit { int pm, pn; };
struct Gemm { const bf16_t* A; const bf16_t* Bt; int M, N, K; };
struct StaticOrder {
    int nM, nN, nwg, G, c;
    __device__ void init(int M, int N, int G_, int c_) { nM = M / BM; nN = N / BM; nwg = nM * nN; G = G_; c = c_; }
    __device__ bool next(int i, Unit& u) const {
        const long L = (long)i * G + c; if (L >= nwg) return false;
        int wgid = (int)L; { const int q = nwg / NXCD, r = nwg % NXCD, xcd = wgid % NXCD, off = wgid / NXCD; wgid = (xcd < r ? xcd * (q + 1) : r * (q + 1) + (xcd - r) * q) + off; }
        const int nig = WGM * nN, gid = wgid / nig, fm = gid * WGM, gsz = (nM - fm) < WGM ? (nM - fm) : WGM;
        u.pm = fm + ((wgid % nig) % gsz); u.pn = (wgid % nig) / gsz; return true;
    }
    __device__ __forceinline__ void a_ready(const Unit&) const {}
    __device__ __forceinline__ void done(const Unit&) const {}
};

template <class Epi, class Sched>
__device__ __forceinline__ void gemm_phase(PG8_LAS unsigned char* lds, const Gemm g, const Sched& S, const Epi& E, int wv) {
    const int tid = tid_l(wv), wid = __builtin_amdgcn_readfirstlane(tid >> 6), lane = tid & 63, wr = wid >> 2, wc = wid & 3, fr = lane & 15, fq = lane >> 4;
    const int K = g.K, nt = K / BK;
    unsigned voffA[2], voffB[2];
#pragma unroll
    for (int i = 0; i < 2; ++i) { int R, C; stage_rc(tid * 16 + i * 8192, R, C); const int Rb = Epi::PERM ? ((R & ~31) + perm32(R & 31)) : R;
        voffA[i] = (unsigned)(R * K + C) * 2u; voffB[i] = (unsigned)(Rb * K + C) * 2u; }
    const size_t kstep = (size_t)(BK * 2);
    const size_t hstep = (size_t)HALF * K * 2;
    const size_t tstep = 2 * hstep;
    const unsigned ldsw = (unsigned)wid * 1024u;
    const int aoff = lds_byte(wr * 64 + fr, fq * 8), boff = lds_byte(wc * 32 + fr, fq * 8);
#define PG8_SA(b, h) (((b) * 2 + (h)) * HTB)
#define PG8_SB(b, h) ((4 + (b) * 2 + (h)) * HTB)
#define PG8_STAGE(bufoff, gbase, voff) do { _Pragma("unroll") for (int _i = 0; _i < 2; ++_i) \
        __builtin_amdgcn_global_load_lds((const unsigned*)((const char*)(gbase) + (voff)[_i]), (PG8_LAS unsigned*)(lds + (bufoff) + ldsw + _i * 8192), 16, 0, 0); } while (0)
#define PG8_LDA(dst, b, h) do { _Pragma("unroll") for (int m = 0; m < 4; ++m) _Pragma("unroll") for (int k = 0; k < 2; ++k) dst[m][k] = *(const PG8_LAS bf16x8*)(lds + PG8_SA(b, h) + aoff + m * 2048 + k * 1024); } while (0)
#define PG8_LDB(dst, b, h) do { _Pragma("unroll") for (int n = 0; n < 2; ++n) _Pragma("unroll") for (int k = 0; k < 2; ++k) dst[n][k] = *(const PG8_LAS bf16x8*)(lds + PG8_SB(b, h) + boff + n * 2048 + k * 1024); } while (0)
#define PG8_MMA(ai, bj, At, Bt) do { __builtin_amdgcn_s_setprio(1); _Pragma("unroll") for (int m = 0; m < 4; ++m) _Pragma("unroll") for (int n = 0; n < 2; ++n) _Pragma("unroll") for (int k = 0; k < 2; ++k) \
        acc[ai][bj][m][n] = __builtin_amdgcn_mfma_f32_16x16x32_bf16(Bt[n][k], At[m][k], acc[ai][bj][m][n], 0, 0, 0); __builtin_amdgcn_s_setprio(0); } while (0)
#define PG8_WAIT_V(n) asm volatile("s_waitcnt vmcnt(" #n ")" ::: "memory")
#define PG8_WAIT_L(n) asm volatile("s_waitcnt lgkmcnt(" #n ")" ::: "memory")
#define PG8_BAR __builtin_amdgcn_s_barrier()
#define PG8_SCHED __builtin_amdgcn_sched_barrier(0)
    Unit cur, nxt; int ui = 0;
    if (!S.next(0, cur)) return;
    f32x4 acc[2][2][4][2];
#pragma unroll
    for (int a = 0; a < 2; ++a)
#pragma unroll
        for (int b = 0; b < 2; ++b)
#pragma unroll
            for (int m = 0; m < 4; ++m)
#pragma unroll
                for (int n = 0; n < 2; ++n) acc[a][b][m][n] = (f32x4){0.f, 0.f, 0.f, 0.f};
    bf16x8 At[4][2], B0[2][2], B1[2][2];
    const char* cA = (const char*)g.A + (size_t)cur.pm * tstep; const char* cB = (const char*)g.Bt + (size_t)cur.pn * tstep;
    S.a_ready(cur);
    PG8_STAGE(PG8_SB(0, 0), cB, voffB); PG8_STAGE(PG8_SA(0, 0), cA, voffA); PG8_STAGE(PG8_SB(0, 1), cB + hstep, voffB); PG8_STAGE(PG8_SA(0, 1), cA + hstep, voffA);
    if (wr == 1) PG8_BAR;
    PG8_WAIT_V(4); PG8_BAR;
    PG8_STAGE(PG8_SB(1, 0), cB + kstep, voffB); PG8_STAGE(PG8_SA(1, 0), cA + kstep, voffA); PG8_STAGE(PG8_SB(1, 1), cB + hstep + kstep, voffB);
    PG8_WAIT_V(6); PG8_BAR;
    for (;;) {
        const bool has_next = S.next(ui + 1, nxt);
        const char* nA = has_next ? (const char*)g.A + (size_t)nxt.pm * tstep : cA; const char* nB = has_next ? (const char*)g.Bt + (size_t)nxt.pn * tstep : cB;
        for (int t = 0; t < nt; t += 2) {
            const bool last = (t == nt - 2);
            const char* a1 = cA + (size_t)(t + 1) * kstep;
            const char* a2 = last ? nA : cA + (size_t)(t + 2) * kstep; const char* b2 = last ? nB : cB + (size_t)(t + 2) * kstep;
            const char* a3 = a2 + kstep; const char* b3 = b2 + kstep;
            if (last && has_next) S.a_ready(nxt);
            PG8_LDB(B0, 0, 0); PG8_SCHED; PG8_LDA(At, 0, 0); PG8_STAGE(PG8_SA(1, 1), a1 + hstep, voffA);
            PG8_WAIT_L(8); PG8_BAR; PG8_WAIT_L(0); PG8_MMA(0, 0, At, B0); PG8_BAR; PG8_SCHED;
            PG8_LDB(B1, 0, 1); PG8_STAGE(PG8_SB(0, 0), b2, voffB);
            PG8_BAR; PG8_WAIT_L(0); PG8_MMA(0, 1, At, B1); PG8_BAR;
            PG8_LDA(At, 0, 1); PG8_STAGE(PG8_SA(0, 0), a2, voffA);
            PG8_BAR; PG8_WAIT_L(0); PG8_MMA(1, 0, At, B0); PG8_BAR; PG8_SCHED;
            PG8_STAGE(PG8_SB(0, 1), b2 + hstep, voffB);
            PG8_WAIT_V(6); PG8_BAR; PG8_MMA(1, 1, At, B1); PG8_BAR;
            PG8_LDB(B0, 1, 0); PG8_SCHED; PG8_LDA(At, 1, 0); PG8_STAGE(PG8_SA(0, 1), a2 + hstep, voffA);
            PG8_WAIT_L(8); PG8_BAR; PG8_WAIT_L(0); PG8_MMA(0, 0, At, B0); PG8_BAR; PG8_SCHED;
            PG8_LDB(B1, 1, 1); PG8_STAGE(PG8_SB(1, 0), b3, voffB);
            PG8_BAR; PG8_WAIT_L(0); PG8_MMA(0, 1, At, B1); PG8_BAR;
            PG8_LDA(At, 1, 1); PG8_STAGE(PG8_SA(1, 0), a3, voffA);
            PG8_BAR; PG8_WAIT_L(0); PG8_MMA(1, 0, At, B0); PG8_BAR; PG8_SCHED;
            PG8_STAGE(PG8_SB(1, 1), b3 + hstep, voffB);
            PG8_WAIT_V(6); PG8_BAR; PG8_MMA(1, 1, At, B1); PG8_BAR;
        }
        E(acc, cur, wr, wc, fr, fq); S.done(cur);
        if (!has_next) break;
#pragma unroll
        for (int a = 0; a < 2; ++a)
#pragma unroll
            for (int b = 0; b < 2; ++b)
#pragma unroll
                for (int m = 0; m < 4; ++m)
#pragma unroll
                    for (int n = 0; n < 2; ++n) acc[a][b][m][n] = (f32x4){0.f, 0.f, 0.f, 0.f};
        cur = nxt; cA = nA; cB = nB; ++ui;
    }
    PG8_WAIT_V(0);
    if (wr == 0) PG8_BAR;
    PG8_BAR;
#undef PG8_SA
#undef PG8_SB
#undef PG8_STAGE
#undef PG8_LDA
#undef PG8_LDB
#undef PG8_MMA
#undef PG8_WAIT_V
#undef PG8_WAIT_L
#undef PG8_BAR
#undef PG8_SCHED
}
}

constexpr float at_QSCALE = 0.125f * 1.4426950408889634f;
struct EpiIn {
    static constexpr bool PERM = true;
    bf16_t* O; const float* rope;
    __device__ __forceinline__ void operator()(const f32x4 (&acc)[2][2][4][2], const pg8::Unit& u, int wr, int wc, int fr, int fq) const {
        const int pn = u.pn;
        const int row0 = u.pm * 256 + wr * 64 + fr, col0 = pn * 256 + wc * 32 + 8 * fq;
        const int fuse = (pn == 0 || pn == 2) ? 1 : (pn == 11 || pn == 14) ? 2 : (pn == 12 || pn == 13) ? 3 : 0;
        const int fcol = (fuse == 1 ? COL_AU + (pn == 2 ? 128 : 0) : fuse == 2 ? COL_CB + (pn == 14 ? 128 : 0) : COL_CC + (pn == 13 ? 128 : 0)) + wc * 32 + 8 * fq;
        const int act = (pn == 1) ? 1 : (pn == 9 || pn == 10) ? 2 : (pn >= 3 && pn <= 6 && u.pm < 64) ? 3 : 0;
        const int axis = wc & 1; const float sgn = fq < 2 ? -1.f : 1.f; const int p0 = 8 * (fq & 1), lane = fq * 16 + fr;
        if (fuse) {
#pragma unroll
            for (int ai = 0; ai < 2; ++ai)
#pragma unroll
                for (int m = 0; m < 4; ++m) {
                    const int row = row0 + ai * 128 + m * 16;
                    f32x4 a0 = acc[ai][0][m][0], a1 = acc[ai][0][m][1], b0 = acc[ai][1][m][0], b1 = acc[ai][1][m][1];
                    if (fuse == 1) {
#pragma unroll
                        for (int j = 0; j < 4; ++j) { a0[j] = gelu_f(a0[j]) * silu_f(b0[j]); a1[j] = gelu_f(a1[j]) * silu_f(b1[j]); } }
                    else if (fuse == 2) {
#pragma unroll
                        for (int j = 0; j < 4; ++j) { a0[j] *= silu_f(b0[j]); a1[j] *= silu_f(b1[j]); } }
                    else { a0 *= b0; a1 *= b1; }
                    u32x4 w; w.x = cvtpk(a0[0], a0[1]); w.y = cvtpk(a0[2], a0[3]); w.z = cvtpk(a1[0], a1[1]); w.w = cvtpk(a1[2], a1[3]);
                    *(u32x4*)(O + (size_t)row * DIN + fcol) = w; }
            return;
        }
        if (act != 3) {
            const float qs = (pn == 3 || pn == 4) ? at_QSCALE : 1.f;
#pragma unroll
            for (int ai = 0; ai < 2; ++ai)
#pragma unroll
                for (int m = 0; m < 4; ++m) {
                    bf16_t* rowp = O + (size_t)(row0 + ai * 128 + m * 16) * DIN + col0;
#pragma unroll
                    for (int bj = 0; bj < 2; ++bj) {
                        f32x4 v0 = acc[ai][bj][m][0], v1 = acc[ai][bj][m][1];
                        if (act == 1) {
#pragma unroll
                            for (int j = 0; j < 4; ++j) { v0[j] = gelu_f(v0[j]); v1[j] = gelu_f(v1[j]); } }
                        else if (act == 2) {
#pragma unroll
                            for (int j = 0; j < 4; ++j) { v0[j] = silu_f(v0[j]); v1[j] = silu_f(v1[j]); } }
                        else { v0 *= qs; v1 *= qs; }
                        u32x4 w; w.x = cvtpk(v0[0], v0[1]); w.y = cvtpk(v0[2], v0[3]); w.z = cvtpk(v1[0], v1[1]); w.w = cvtpk(v1[2], v1[3]);
                        *(u32x4*)(rowp + bj * 128) = w; } }
            return;
        }
        f32x4 rc0[4], rc1[4], rs0[4], rs1[4];
#pragma unroll
        for (int ai = 0; ai < 2; ++ai)
#pragma unroll
            for (int m = 0; m < 4; ++m) {
                const int row = row0 + ai * 128 + m * 16;
                bf16_t* rowp = O + (size_t)row * DIN + col0;
                f32x4 c0 = {1.f, 1.f, 1.f, 1.f}, c1 = c0, s0 = {0.f, 0.f, 0.f, 0.f}, s1 = s0;
                if (act == 3) {
                    if (axis ? (ai == 0) : (m == 0)) { const int t = row & (SEQ - 1); const int pos = axis ? (t & 63) : (t >> 6); const float* tp = rope + pos * 16 + p0;
                        const f32x4 tc0 = *(const f32x4*)tp, tc1 = *(const f32x4*)(tp + 4), ts0 = *(const f32x4*)(tp + 2048) * sgn, ts1 = *(const f32x4*)(tp + 2052) * sgn;
                        if (axis) { rc0[m] = tc0; rc1[m] = tc1; rs0[m] = ts0; rs1[m] = ts1; } else { rc0[0] = tc0; rc1[0] = tc1; rs0[0] = ts0; rs1[0] = ts1; } }
                    const int sel = axis ? m : 0; c0 = rc0[sel]; c1 = rc1[sel]; s0 = rs0[sel]; s1 = rs1[sel]; }
#pragma unroll
                for (int bj = 0; bj < 2; ++bj) {
                    f32x4 v0 = acc[ai][bj][m][0], v1 = acc[ai][bj][m][1];
                    if (act == 1) {
#pragma unroll
                        for (int j = 0; j < 4; ++j) { v0[j] = gelu_f(v0[j]); v1[j] = gelu_f(v1[j]); } }
                    else if (act == 2) {
#pragma unroll
                        for (int j = 0; j < 4; ++j) { v0[j] = silu_f(v0[j]); v1[j] = silu_f(v1[j]); } }
                    else if (act == 3) {
                        f32x4 q0, q1;
#pragma unroll
                        for (int j = 0; j < 4; ++j) { q0[j] = swap32(v0[j], fq >> 1); q1[j] = swap32(v1[j], fq >> 1); }
                        v0 = v0 * c0 + q0 * s0; v1 = v1 * c1 + q1 * s1; }
                    if (pn == 3 || pn == 4) { v0 *= at_QSCALE; v1 *= at_QSCALE; }
                    u32x4 w; w.x = cvtpk(v0[0], v0[1]); w.y = cvtpk(v0[2], v0[3]); w.z = cvtpk(v1[0], v1[1]); w.w = cvtpk(v1[2], v1[3]);
                    *(u32x4*)(rowp + bj * 128) = w; }
            }
    }
};
struct EpiOut {
    static constexpr bool PERM = false;
    const float* src_lat; const float* src_ctx; float* dst_lat; float* dst_ctx; const float* modl;
    __device__ __forceinline__ void operator()(const f32x4 (&acc)[2][2][4][2], const pg8::Unit& u, int wr, int wc, int fr, int fq) const {
        const int cnd = u.pm < 32 ? 0 : u.pm < 64 ? 1 : 2;
        const int lrow0 = (u.pm < 64 ? u.pm * 256 : (u.pm - 64) * 256) + wr * 64 + fr, col0 = u.pn * 256 + wc * 32 + 4 * fq;
        const float* sp = (u.pm < 64 ? src_lat : src_ctx); float* dp = (u.pm < 64 ? dst_lat : dst_ctx);
        const float* gate = modl + cnd * 3072 + 2048 + col0;
        f32x4 gv[2][2];
#pragma unroll
        for (int bj = 0; bj < 2; ++bj)
#pragma unroll
            for (int n = 0; n < 2; ++n) gv[bj][n] = *(const f32x4*)(gate + bj * 128 + n * 16);
#pragma unroll
        for (int ai = 0; ai < 2; ++ai) {
            f32x4 xs[4][2][2];
#pragma unroll
            for (int m = 0; m < 4; ++m) { const size_t ro = (size_t)(lrow0 + ai * 128 + m * 16) * DM + col0;
#pragma unroll
                for (int bj = 0; bj < 2; ++bj)
#pragma unroll
                    for (int n = 0; n < 2; ++n) xs[m][bj][n] = *(const f32x4*)(sp + ro + bj * 128 + n * 16); }
#pragma unroll
            for (int m = 0; m < 4; ++m) { const size_t ro = (size_t)(lrow0 + ai * 128 + m * 16) * DM + col0;
#pragma unroll
                for (int bj = 0; bj < 2; ++bj)
#pragma unroll
                    for (int n = 0; n < 2; ++n) *(f32x4*)(dp + ro + bj * 128 + n * 16) = xs[m][bj][n] + gv[bj][n] * acc[ai][bj][m][n]; }
        }
    }
};

namespace at {
constexpr int KVBLK = 64;
constexpr float QSCALE = 0.125f * 1.4426950408889634f;
constexpr float THR2 = 8.f * 1.4426950408889634f;
constexpr int SHM_V = KVBLK * 128 * 2, SHM_K = KVBLK * 128 * 2;
#define KSWZ(row, colB) ((row) * 256 + ((colB) ^ (((row) & 15) << 4)))
#define SBAR() __builtin_amdgcn_sched_barrier(0)
__device__ __forceinline__ int crow(int r, int hi) { return (r & 3) + 8 * (r >> 2) + 4 * hi; }
__device__ __forceinline__ void partialSM(f32x16& p0, f32x16& p1, float& m_reg, float& mn, float& alpha) {
    float pmax = p0[0];
#pragma unroll
    for (int r = 1; r < 16; ++r) pmax = fmaxf(pmax, p0[r]);
#pragma unroll
    for (int r = 0; r < 16; ++r) pmax = fmaxf(pmax, p1[r]);
    { auto rr = __builtin_amdgcn_permlane32_swap(__float_as_uint(pmax), __float_as_uint(pmax), false, false);
      pmax = fmaxf(__uint_as_float(rr[0]), __uint_as_float(rr[1])); }
    if (__builtin_expect(__all(pmax - m_reg <= THR2), 1)) { mn = m_reg; alpha = 1.f; }
    else { mn = fmaxf(m_reg, pmax); alpha = __builtin_amdgcn_exp2f(m_reg - mn); m_reg = mn; }
#pragma unroll
    for (int r = 0; r < 16; ++r) p0[r] -= mn;
#pragma unroll
    for (int r = 0; r < 16; ++r) p1[r] -= mn;
#pragma unroll
    for (int r = 0; r < 16; ++r) p0[r] = __builtin_amdgcn_exp2f(p0[r]);
}
__device__ __forceinline__ void finishSM(f32x16& p0, f32x16& p1, float alpha, float& l_reg, bf16x8& pa0, bf16x8& pa1, bf16x8& pa2, bf16x8& pa3) {
#pragma unroll
    for (int r = 0; r < 16; ++r) p1[r] = __builtin_amdgcn_exp2f(p1[r]);
    float ps = 0;
#pragma unroll
    for (int r = 0; r < 16; ++r) ps += p0[r];
#pragma unroll
    for (int r = 0; r < 16; ++r) ps += p1[r];
    { auto rr = __builtin_amdgcn_permlane32_swap(__float_as_uint(ps), __float_as_uint(ps), false, false);
      ps = __uint_as_float(rr[0]) + __uint_as_float(rr[1]); }
    l_reg = l_reg * alpha + ps;
#define PK4(P, BASE, OUT) do { unsigned a0 = cvtpk(P[BASE + 0], P[BASE + 1]), a1 = cvtpk(P[BASE + 2], P[BASE + 3]);   \
    unsigned b0 = cvtpk(P[BASE + 4], P[BASE + 5]), b1 = cvtpk(P[BASE + 6], P[BASE + 7]);                              \
    auto r0 = __builtin_amdgcn_permlane32_swap(a0, b0, false, false); auto r1 = __builtin_amdgcn_permlane32_swap(a1, b1, false, false); \
    u32x4 w = {r0[0], r1[0], r0[1], r1[1]}; OUT = *reinterpret_cast<bf16x8*>(&w); } while (0)
    PK4(p0, 0, pa0); PK4(p0, 8, pa1); PK4(p1, 0, pa2); PK4(p1, 8, pa3);
#undef PK4
}
__device__ __forceinline__ void qkt(f32x16& p0, f32x16& p1, const char* Ks, const bf16x8* qr, int r32, int hi, int mcolB) {
    p0 = f32x16{}; p1 = f32x16{};
#pragma unroll
    for (int d0 = 0; d0 < 4; ++d0) { const int cb = mcolB + (d0 * 16 + hi * 8) * 2;
        const bf16x8 b0 = *reinterpret_cast<const bf16x8*>(Ks + KSWZ(r32, cb));
        const bf16x8 b1 = *reinterpret_cast<const bf16x8*>(Ks + KSWZ(32 + r32, cb));
        p0 = __builtin_amdgcn_mfma_f32_32x32x16_bf16(b0, qr[d0], p0, 0, 0, 0);
        p1 = __builtin_amdgcn_mfma_f32_32x32x16_bf16(b1, qr[d0], p1, 0, 0, 0); }
}
__device__ __forceinline__ int v_st(int k, int c) { const int kk = (k & ~0xC) | ((k & 4) << 1) | ((k & 8) >> 1); return ((kk >> 3) * 4 + (c >> 5)) * 512 + ((kk & 7) * 32 + (c & 31)) * 2; }
__device__ __forceinline__ int v_rd_base(int lane) { return ((lane & 3) << 3) | (((lane >> 2) & 3) << 6) | (((lane >> 4) & 1) << 5) | (((lane >> 5) & 1) << 8); }
constexpr int v_rd_off(int d0, int ks, int half) { return d0 * 512 + ks * 4096 + half * 2048; }
template <int OFF> __device__ __forceinline__ s16x4 tr_read(int vb) {
    s16x4 r; asm volatile("ds_read_b64_tr_b16 %0, %1 offset:%2" : "=&v"(r) : "v"(vb), "i"(OFF) : "memory"); return r;
}
template <int D0> __device__ __forceinline__ void pv_one(f32x16& od, int vb, bf16x8 pa0, bf16x8 pa1, bf16x8 pa2, bf16x8 pa3) {
    const s16x4 l0 = tr_read<v_rd_off(D0, 0, 0)>(vb), h0 = tr_read<v_rd_off(D0, 0, 1)>(vb), l1 = tr_read<v_rd_off(D0, 1, 0)>(vb), h1 = tr_read<v_rd_off(D0, 1, 1)>(vb);
    const s16x4 l2 = tr_read<v_rd_off(D0, 2, 0)>(vb), h2 = tr_read<v_rd_off(D0, 2, 1)>(vb), l3 = tr_read<v_rd_off(D0, 3, 0)>(vb), h3 = tr_read<v_rd_off(D0, 3, 1)>(vb);
    asm volatile("s_waitcnt lgkmcnt(0)" ::: "memory"); SBAR();
#define PK(L, H) (bf16x8){L[0], L[1], L[2], L[3], H[0], H[1], H[2], H[3]}
    od = __builtin_amdgcn_mfma_f32_32x32x16_bf16(pa0, PK(l0, h0), od, 0, 0, 0);
    od = __builtin_amdgcn_mfma_f32_32x32x16_bf16(pa1, PK(l1, h1), od, 0, 0, 0);
    od = __builtin_amdgcn_mfma_f32_32x32x16_bf16(pa2, PK(l2, h2), od, 0, 0, 0);
    od = __builtin_amdgcn_mfma_f32_32x32x16_bf16(pa3, PK(l3, h3), od, 0, 0, 0);
#undef PK
}
__device__ __forceinline__ void pv_d0(f32x16* o, int vb, bf16x8 pa0, bf16x8 pa1, bf16x8 pa2, bf16x8 pa3) {
    pv_one<0>(o[0], vb, pa0, pa1, pa2, pa3); pv_one<1>(o[1], vb, pa0, pa1, pa2, pa3); pv_one<2>(o[2], vb, pa0, pa1, pa2, pa3); pv_one<3>(o[3], vb, pa0, pa1, pa2, pa3);
}

__device__ __forceinline__ void attn_epilogue(f32x16* o, float l_full, const bf16_t* __restrict__ Pb, bf16_t* __restrict__ Yb, int qrow0, int h, const float* __restrict__ lamp, const float* __restrict__ subg, char* lds, float* li_l, int wv) {
    const float lam = lamp[0], obs = lamp[DEPTH];
    const int tid = tid_l(wv), wid = tid >> 6, lane = tid & 63, r32 = lane & 31, hi = lane >> 5, rg = wid & 3, mm = wid >> 2;
    if (hi == 0) li_l[r32] = l_full; asm volatile("s_waitcnt lgkmcnt(0)" ::: "memory");
    float rli[16];
#pragma unroll
    for (int r = 0; r < 16; ++r) rli[r] = __builtin_amdgcn_rcpf(li_l[crow(r, hi)]);
    float* cbuf = (float*)lds + rg * 4096 + lane;
    bf16x8 gz[4];
#pragma unroll
    for (int jj = 0; jj < 4; ++jj) { const int c = tid + 512 * jj, row = c >> 4, col8 = (c & 15) * 8;
        gz[jj] = *reinterpret_cast<const bf16x8*>(Pb + (size_t)(qrow0 + row) * DIN + COL_BZ + h * 128 + col8); }
    if (mm == 1) {
#pragma unroll
        for (int d0 = 0; d0 < 4; ++d0)
#pragma unroll
            for (int r = 0; r < 16; ++r) cbuf[(d0 * 16 + r) * 64] = -lam * o[d0][r] * rli[r];
    }
    __syncthreads();
    if (mm == 0) {
        float ss[16];
#pragma unroll
        for (int r = 0; r < 16; ++r) ss[r] = 0.f;
#pragma unroll
        for (int d0 = 0; d0 < 4; ++d0)
#pragma unroll
            for (int r = 0; r < 16; ++r) { const float v = o[d0][r] * rli[r] + cbuf[(d0 * 16 + r) * 64]; o[d0][r] = v; ss[r] += v * v; }
#pragma unroll
        for (int r = 0; r < 16; ++r) { float sq = row16_sum(ss[r]); sq += shx(sq, lane, 16);
            ss[r] = __builtin_amdgcn_rsqf(sq * (1.f / 128.f) + EPS) * obs; }
#pragma unroll
        for (int d0 = 0; d0 < 4; ++d0) { const float gs = subg[d0 * 32 + r32];
#pragma unroll
            for (int r = 0; r < 16; ++r) cbuf[(d0 * 16 + r) * 64] = o[d0][r] * ss[r] * gs; }
    }
    __syncthreads();
    {
        const float* cb0 = (const float*)lds;
#pragma unroll
        for (int jj = 0; jj < 4; ++jj) { const int c = tid + 512 * jj, row = c >> 4, col8 = (c & 15) * 8;
            const int d0 = col8 >> 5, rb = col8 & 31, rgq = row >> 5, within = row & 31, hiq = (within >> 2) & 1, r = (within & 3) + 4 * (within >> 3);
            const float* mp = cb0 + ((rgq * 4 + d0) * 16 + r) * 64 + hiq * 32 + rb;
            const f32x4 m0 = *(const f32x4*)mp, m1 = *(const f32x4*)(mp + 4);
            u32x4 w = {cvtpk(m0[0] * bf2f(gz[jj][0]), m0[1] * bf2f(gz[jj][1])), cvtpk(m0[2] * bf2f(gz[jj][2]), m0[3] * bf2f(gz[jj][3])),
                       cvtpk(m1[0] * bf2f(gz[jj][4]), m1[1] * bf2f(gz[jj][5])), cvtpk(m1[2] * bf2f(gz[jj][6]), m1[3] * bf2f(gz[jj][7]))};
            *(u32x4*)(Yb + (size_t)(qrow0 + row) * DM + YB + h * 128 + col8) = w; }
    }
    __syncthreads();
}

__device__ __forceinline__ void attn_unit_exact(const bf16_t* __restrict__ Pb, bf16_t* __restrict__ Yb, int qrow0, int b, int h, int NT, const float* __restrict__ lamp, const float* __restrict__ subg, char* lds, int wv) {
    const int tid = tid_l(wv), wid = tid >> 6, lane = tid & 63, r32 = lane & 31, hi = lane >> 5, rg = wid & 3, mm = wid >> 2;
    char* V_lds = lds; char* K_lds = lds + 2 * SHM_V;
    float* wsl = (float*)(lds + 8 * SHM_V) + wid * 64; float* li_l = wsl; float* al_l = wsl + 32;
    float m_reg = -1e30f, l_reg = 0; f32x16 o[4] = {}; bf16x8 qr[4];
    const bf16_t* Qw = Pb + (size_t)(qrow0 + rg * 32 + r32) * DIN + COL_Q + h * 128 + mm * 64 + hi * 8;
#pragma unroll
    for (int d0 = 0; d0 < 4; ++d0) qr[d0] = *reinterpret_cast<const bf16x8*>(Qw + d0 * 16);
    const int sr = tid >> 4, sc = (tid & 15) * 8, vst0 = v_st(sr, sc), vst1 = v_st(32 + sr, sc);
    const int vb0 = (int)(uintptr_t)V_lds + v_rd_base(lane);
    const int mcolB = mm * 128;
    const bf16_t* kvc = Pb + (size_t)(NLAT + b * CTXL + sr) * DIN + h * 128 + sc;
    const bf16_t* kvl = Pb + (size_t)(b * SEQ + sr) * DIN + h * 128 + sc - (size_t)256 * DIN;
    struct { bf16x8 vs0, vs1, ks0, ks1; } sr_[1];
#define SLOAD(i, j) do { const bf16_t* _b = ((j) < 4 ? kvc : kvl) + (size_t)(j) * 64 * DIN; \
    sr_[i].vs0 = *reinterpret_cast<const bf16x8*>(_b + COL_V); sr_[i].vs1 = *reinterpret_cast<const bf16x8*>(_b + COL_V + 32 * DIN); \
    sr_[i].ks0 = *reinterpret_cast<const bf16x8*>(_b + COL_K); sr_[i].ks1 = *reinterpret_cast<const bf16x8*>(_b + COL_K + 32 * DIN); } while (0)
#define SWRITE(bb, i) do { *(bf16x8*)(V_lds + (bb) * SHM_V + vst0) = sr_[i].vs0;          \
    *(bf16x8*)(V_lds + (bb) * SHM_V + vst1) = sr_[i].vs1; const int kc = sc * 2;               \
    *(bf16x8*)(K_lds + (bb) * SHM_K + KSWZ(sr, kc)) = sr_[i].ks0;                       \
    *(bf16x8*)(K_lds + (bb) * SHM_K + KSWZ(32 + sr, kc)) = sr_[i].ks1; } while (0)
#define SWAIT() asm volatile("s_waitcnt vmcnt(4)" ::: "memory")
#define RESC(a) do { if (__any((a) < 1.f)) { if (hi == 0) al_l[r32] = (a); asm volatile("s_waitcnt lgkmcnt(0)" ::: "memory"); \
    _Pragma("unroll") for (int d = 0; d < 4; ++d) _Pragma("unroll") for (int r = 0; r < 16; ++r) o[d][r] *= al_l[crow(r, hi)]; } } while (0)
    f32x16 p0, p1; float mn, al; bf16x8 pa0, pa1, pa2, pa3;
    for (int j = 0; j < NT; ++j) {
        SLOAD(0, j); asm volatile("s_waitcnt vmcnt(0)" ::: "memory"); SWRITE(0, 0); __syncthreads();
        qkt(p0, p1, K_lds, qr, r32, hi, mcolB); partialSM(p0, p1, m_reg, mn, al);
        RESC(al);
        finishSM(p0, p1, al, l_reg, pa0, pa1, pa2, pa3); SBAR();
        pv_d0(o, vb0, pa0, pa1, pa2, pa3);
        __syncthreads();
    }
    attn_epilogue(o, l_reg, Pb, Yb, qrow0, h, lamp, subg, lds, li_l, wv);
#undef SLOAD
#undef SWRITE
#undef SWAIT
#undef RESC
}

__device__ __forceinline__ void attn_unit(const bf16_t* __restrict__ Pb, bf16_t* __restrict__ Yb, int qrow0, int b, int h, int NT, const float* __restrict__ lamp, const float* __restrict__ subg, char* lds, PG8_LAS unsigned char* ldsa, int wv) {
    const int tid = tid_l(wv), wid = __builtin_amdgcn_readfirstlane(tid >> 6), lane = tid & 63, r32 = lane & 31, hi = lane >> 5, rg = wid & 3, mm = wid >> 2;
    char* V_lds = lds; char* K_lds = lds + 4 * SHM_V;
    float* li_l = (float*)(lds + 8 * SHM_V) + wid * 64;
    float l_acc = 0.f; f32x16 o[4] = {}; bf16x8 qr[4];
    const bf16_t* Qw = Pb + (size_t)(qrow0 + rg * 32 + r32) * DIN + COL_Q + h * 128 + mm * 64 + hi * 8;
#pragma unroll
    for (int d0 = 0; d0 < 4; ++d0) qr[d0] = *reinterpret_cast<const bf16x8*>(Qw + d0 * 16);
    const int vb0 = (int)(uintptr_t)V_lds + v_rd_base(lane);
    const int mcolB = mm * 128;
    unsigned koff[2], voff[2];
#pragma unroll
    for (int i = 0; i < 2; ++i) { const int ci = wid * 128 + i * 64 + lane;
        { const int row = ci >> 4, cc = (ci & 15) ^ (row & 15); koff[i] = (unsigned)(row * DIN + COL_K + h * 128 + cc * 8) * 2u; }
        { const int sub = ci >> 5, k = (sub >> 2) * 8 + ((ci & 31) >> 2), c = (sub & 3) * 32 + (ci & 3) * 8; voff[i] = (unsigned)(k * DIN + COL_V + h * 128 + c) * 2u; } }
    const bf16_t* kvc = Pb + (size_t)(NLAT + b * CTXL) * DIN;
    const bf16_t* kvl = Pb + (size_t)(b * SEQ) * DIN - (size_t)256 * DIN;
#define KVBASE(t) ((const char*)(((t) < 4 ? kvc : kvl) + (size_t)(t) * 64 * DIN))
#define DMAV2(t, tb) do { const char* _b = KVBASE(t); const int _bo = ((tb) & 3) * SHM_V + wid * 2048; \
    _Pragma("unroll") for (int _i = 0; _i < 2; ++_i) __builtin_amdgcn_global_load_lds((const unsigned*)(_b + voff[_i]), (PG8_LAS unsigned*)(ldsa + _bo + _i * 1024), 16, 0, 0); } while (0)
#define DMAK2(t, tb) do { const char* _b = KVBASE(t); const int _bo = ((tb) & 3) * SHM_V + wid * 2048; \
    _Pragma("unroll") for (int _i = 0; _i < 2; ++_i) __builtin_amdgcn_global_load_lds((const unsigned*)(_b + koff[_i]), (PG8_LAS unsigned*)(ldsa + 4 * SHM_V + _bo + _i * 1024), 16, 0, 0); } while (0)
#define BOFF(t) (((t) & 3) * SHM_V)
#define QKTF(P0, P1, Ks) do { _Pragma("unroll") for (int d0 = 0; d0 < 4; ++d0) { const int cb = mcolB + (d0 * 16 + hi * 8) * 2; \
        const bf16x8 kb0 = *reinterpret_cast<const bf16x8*>((Ks) + KSWZ(r32, cb)); const bf16x8 kb1 = *reinterpret_cast<const bf16x8*>((Ks) + KSWZ(32 + r32, cb)); \
        P0 = __builtin_amdgcn_mfma_f32_32x32x16_bf16(kb0, qr[d0], d0 == 0 ? NI : P0, 0, 0, 0); P1 = __builtin_amdgcn_mfma_f32_32x32x16_bf16(kb1, qr[d0], d0 == 0 ? NI : P1, 0, 0, 0); \
        if (d0 == 1) SBAR(); } } while (0)
#define EXPH(P) do { _Pragma("unroll") for (int r = 0; r < 16; ++r) P[r] = __builtin_amdgcn_exp2f(P[r]); } while (0)
#define PK4(P, BASE, OUT) do { unsigned a0 = cvtpk(P[BASE + 0], P[BASE + 1]), a1 = cvtpk(P[BASE + 2], P[BASE + 3]);   \
    unsigned b0 = cvtpk(P[BASE + 4], P[BASE + 5]), b1 = cvtpk(P[BASE + 6], P[BASE + 7]);                              \
    auto r0 = __builtin_amdgcn_permlane32_swap(a0, b0, false, false); auto r1 = __builtin_amdgcn_permlane32_swap(a1, b1, false, false); \
    u32x4 w = {r0[0], r1[0], r0[1], r1[1]}; OUT = *reinterpret_cast<bf16x8*>(&w); } while (0)
#define FINF(P0, P1) do { EXPH(P1); float s0 = P0[0] + P1[0], s1 = P0[1] + P1[1], s2 = P0[2] + P1[2], s3 = P0[3] + P1[3]; \
    _Pragma("unroll") for (int r = 4; r < 16; r += 4) { s0 += P0[r] + P1[r]; s1 += P0[r + 1] + P1[r + 1]; s2 += P0[r + 2] + P1[r + 2]; s3 += P0[r + 3] + P1[r + 3]; } \
    l_acc += (s0 + s1) + (s2 + s3); PK4(P0, 0, pa0); PK4(P0, 8, pa1); PK4(P1, 0, pa2); PK4(P1, 8, pa3); } while (0)
    f32x16 pA0, pA1, pB0, pB1, NI; bf16x8 pa0, pa1, pa2, pa3;
    const int kbase = (int)(uintptr_t)K_lds;
    const int kad0 = kbase + KSWZ(r32, mcolB + (0 * 16 + hi * 8) * 2), kad1 = kbase + KSWZ(r32, mcolB + (1 * 16 + hi * 8) * 2),
              kad2 = kbase + KSWZ(r32, mcolB + (2 * 16 + hi * 8) * 2), kad3 = kbase + KSWZ(r32, mcolB + (3 * 16 + hi * 8) * 2);
#define RBAR() do { asm volatile("" ::: "memory"); __builtin_amdgcn_s_barrier(); asm volatile("" ::: "memory"); } while (0)
    DMAK2(0, 0); DMAK2(1, 1); DMAK2(2, 2); DMAV2(0, 0); DMAV2(1, 1);
    asm volatile("s_waitcnt vmcnt(0)" ::: "memory"); RBAR();
    {
        qkt(pA0, pA1, K_lds, qr, r32, hi, mcolB);
        float pmax = pA0[0];
#pragma unroll
        for (int r = 1; r < 16; ++r) pmax = fmaxf(pmax, pA0[r]);
#pragma unroll
        for (int r = 0; r < 16; ++r) pmax = fmaxf(pmax, pA1[r]);
        { auto rr = __builtin_amdgcn_permlane32_swap(__float_as_uint(pmax), __float_as_uint(pmax), false, false); pmax = fmaxf(__uint_as_float(rr[0]), __uint_as_float(rr[1])); }
#pragma unroll
        for (int r = 0; r < 16; ++r) NI[r] = -pmax;
    }
    QKTF(pA0, pA1, K_lds); EXPH(pA0);
#define EXP4(P, B) do { P[B] = __builtin_amdgcn_exp2f(P[B]); P[B + 1] = __builtin_amdgcn_exp2f(P[B + 1]); P[B + 2] = __builtin_amdgcn_exp2f(P[B + 2]); P[B + 3] = __builtin_amdgcn_exp2f(P[B + 3]); } while (0)
#define KFR(d0, half) (*reinterpret_cast<const bf16x8*>(_ks + KSWZ((half) * 32 + r32, mcolB + ((d0) * 16 + hi * 8) * 2)))
#define LOADG(F, KS, VB) do { F##0l = tr_read<v_rd_off(0, KS, 0)>(VB); F##0h = tr_read<v_rd_off(0, KS, 1)>(VB); F##1l = tr_read<v_rd_off(1, KS, 0)>(VB); F##1h = tr_read<v_rd_off(1, KS, 1)>(VB); \
    F##2l = tr_read<v_rd_off(2, KS, 0)>(VB); F##2h = tr_read<v_rd_off(2, KS, 1)>(VB); F##3l = tr_read<v_rd_off(3, KS, 0)>(VB); F##3h = tr_read<v_rd_off(3, KS, 1)>(VB); } while (0)
#define PIN(x) asm volatile("" : "+v"(x))
#define EXP2E(P, i) do { P[i] = __builtin_amdgcn_exp2f(P[i]); P[(i) + 1] = __builtin_amdgcn_exp2f(P[(i) + 1]); } while (0)
#define SWP(r, a, b) do { auto _r = __builtin_amdgcn_permlane32_swap(a, b, false, false); r##x = _r[0]; r##y = _r[1]; PIN(r##x); PIN(r##y); } while (0)
#define MKPA(OUT, r0, r1) do { u32x4 _w = {r0##x, r1##x, r0##y, r1##y}; OUT = *reinterpret_cast<bf16x8*>(&_w); PIN(OUT); } while (0)
#define QKM(N, kf, d0, C) do { PIN(kf); N = __builtin_amdgcn_mfma_f32_32x32x16_bf16(kf, qr[d0], C, 0, 0, 0); PIN(N); } while (0)
#define PKN(OUT, P, B) do { u32x4 _w = {cvtpk(P[B], P[B + 1]), cvtpk(P[B + 2], P[B + 3]), cvtpk(P[B + 4], P[B + 5]), cvtpk(P[B + 6], P[B + 7])}; OUT = *reinterpret_cast<bf16x8*>(&_w); PIN(OUT); } while (0)
#define PKH(W, P, B) do { W = cvtpk(P[B], P[B + 1]); } while (0)
#define KRD(dst, addr, OFF) asm volatile("ds_read_b128 %0, %1 offset:" #OFF : "=&v"(dst) : "v"(addr) : "memory")
#define WAITK(n, ka, kb) asm volatile("s_waitcnt lgkmcnt(" #n ")" : "+v"(ka), "+v"(kb) :: "memory")
#define H1STEP(P0, P1, N0, N1, KOFF, VBN) do { const int _ko = (KOFF); unsigned _w0, _w1, _w2, _w3; bf16x8 k00, k01, k10, k11, k20, k21, k30, k31; \
    { const int _a0 = kad0 + _ko, _a1 = kad1 + _ko, _a2 = kad2 + _ko, _a3 = kad3 + _ko; \
      KRD(k00, _a0, 0); KRD(k01, _a0, 8192); KRD(k10, _a1, 0); KRD(k11, _a1, 8192); KRD(k20, _a2, 0); KRD(k21, _a2, 8192); KRD(k30, _a3, 0); KRD(k31, _a3, 8192); } \
    PIN(P1); PIN(P0); \
    WAITK(6, k00, k01); \
    QKM(N0, k00, 0, NI); EXP2E(P1, 0);  PIN(P1); PKH(_w0, P0, 0); \
    QKM(N1, k01, 0, NI); EXP2E(P1, 2);  PIN(P1); PKH(_w1, P0, 2); \
    WAITK(4, k10, k11); \
    QKM(N0, k10, 1, N0); EXP2E(P1, 4);  PIN(P1); PKH(_w2, P0, 4); \
    QKM(N1, k11, 1, N1); EXP2E(P1, 6);  PIN(P1); PKH(_w3, P0, 6); { u32x4 _w = {_w0, _w1, _w2, _w3}; pa0 = *reinterpret_cast<bf16x8*>(&_w); PIN(pa0); } \
    WAITK(2, k20, k21); \
    QKM(N0, k20, 2, N0); EXP2E(P1, 8);  PIN(P1); PKH(_w0, P0, 8); \
    QKM(N1, k21, 2, N1); EXP2E(P1, 10); PIN(P1); PKH(_w1, P0, 10); \
    WAITK(0, k30, k31); \
    QKM(N0, k30, 3, N0); EXP2E(P1, 12); PIN(P1); PKH(_w2, P0, 12); \
    QKM(N1, k31, 3, N1); EXP2E(P1, 14); PIN(P1); PKH(_w3, P0, 14); { u32x4 _w = {_w0, _w1, _w2, _w3}; pa1 = *reinterpret_cast<bf16x8*>(&_w); PIN(pa1); } \
    LOADG(fa, 0, VBN); LOADG(fb, 1, VBN); } while (0)
#define PKV(L, H) (bf16x8){L[0], L[1], L[2], L[3], H[0], H[1], H[2], H[3]}
#define PVM(i, PA, FL, FH) do { o[i] = __builtin_amdgcn_mfma_f32_32x32x16_bf16(PA, PKV(FL, FH), o[i], 0, 0, 0); PIN(o[i]); } while (0)
#define SUM2(g, A0, A1) do { _s0 += A0[2 * (g)] + A1[2 * (g)]; _s1 += A0[2 * (g) + 1] + A1[2 * (g) + 1]; PIN(_s0); PIN(_s1); } while (0)
#define WAITL(n, F) asm volatile("s_waitcnt lgkmcnt(" #n ")" : "+v"(F##0l), "+v"(F##0h), "+v"(F##1l), "+v"(F##1h), "+v"(F##2l), "+v"(F##2h), "+v"(F##3l), "+v"(F##3h) :: "memory")
#define H2STEP(VB, P0, P1, N0) do { const int _vb = (VB); unsigned _w0, _w1, _w2, _w3; float _s0 = 0.f, _s1 = 0.f; \
    PIN(N0); PIN(P1); \
    WAITL(8, fa); \
    PVM(0, pa0, fa0l, fa0h); SUM2(0, P0, P1); PKH(_w0, P1, 0); \
    PVM(1, pa0, fa1l, fa1h); SUM2(1, P0, P1); PKH(_w1, P1, 2); \
    PVM(2, pa0, fa2l, fa2h); SUM2(2, P0, P1); PKH(_w2, P1, 4); \
    PVM(3, pa0, fa3l, fa3h); SUM2(3, P0, P1); PKH(_w3, P1, 6); { u32x4 _w = {_w0, _w1, _w2, _w3}; pa2 = *reinterpret_cast<bf16x8*>(&_w); PIN(pa2); } \
    LOADG(fa, 2, _vb); WAITL(8, fb); \
    PVM(0, pa1, fb0l, fb0h); SUM2(4, P0, P1); PKH(_w0, P1, 8); \
    PVM(1, pa1, fb1l, fb1h); SUM2(5, P0, P1); PKH(_w1, P1, 10); \
    PVM(2, pa1, fb2l, fb2h); SUM2(6, P0, P1); PKH(_w2, P1, 12); \
    PVM(3, pa1, fb3l, fb3h); SUM2(7, P0, P1); PKH(_w3, P1, 14); { u32x4 _w = {_w0, _w1, _w2, _w3}; pa3 = *reinterpret_cast<bf16x8*>(&_w); PIN(pa3); } l_acc += _s0 + _s1; PIN(l_acc); \
    LOADG(fb, 3, _vb); WAITL(8, fa); \
    PVM(0, pa2, fa0l, fa0h); EXP2E(N0, 0);  PIN(N0); \
    PVM(1, pa2, fa1l, fa1h); EXP2E(N0, 2);  PIN(N0); \
    PVM(2, pa2, fa2l, fa2h); EXP2E(N0, 4);  PIN(N0); \
    PVM(3, pa2, fa3l, fa3h); EXP2E(N0, 6);  PIN(N0); \
    WAITL(0, fb); \
    PVM(0, pa3, fb0l, fb0h); EXP2E(N0, 8);  PIN(N0); \
    PVM(1, pa3, fb1l, fb1h); EXP2E(N0, 10); PIN(N0); \
    PVM(2, pa3, fb2l, fb2h); EXP2E(N0, 12); PIN(N0); \
    PVM(3, pa3, fb3l, fb3h); EXP2E(N0, 14); PIN(N0); } while (0)
#define H1LAST(P0, P1, VBN) do { unsigned _w0, _w1, _w2, _w3; \
    PIN(P1); PIN(P0); \
    EXP2E(P1, 0);  PIN(P1); PKH(_w0, P0, 0); \
    EXP2E(P1, 2);  PIN(P1); PKH(_w1, P0, 2); \
    EXP2E(P1, 4);  PIN(P1); PKH(_w2, P0, 4); \
    EXP2E(P1, 6);  PIN(P1); PKH(_w3, P0, 6); { u32x4 _w = {_w0, _w1, _w2, _w3}; pa0 = *reinterpret_cast<bf16x8*>(&_w); PIN(pa0); } \
    EXP2E(P1, 8);  PIN(P1); PKH(_w0, P0, 8); \
    EXP2E(P1, 10); PIN(P1); PKH(_w1, P0, 10); \
    EXP2E(P1, 12); PIN(P1); PKH(_w2, P0, 12); \
    EXP2E(P1, 14); PIN(P1); PKH(_w3, P0, 14); { u32x4 _w = {_w0, _w1, _w2, _w3}; pa1 = *reinterpret_cast<bf16x8*>(&_w); PIN(pa1); } \
    LOADG(fa, 0, VBN); LOADG(fb, 1, VBN); } while (0)
#define H2LAST(VB, P0, P1) do { const int _vb = (VB); unsigned _w0, _w1, _w2, _w3; float _s0 = 0.f, _s1 = 0.f; \
    PIN(P1); \
    WAITL(8, fa); \
    PVM(0, pa0, fa0l, fa0h); SUM2(0, P0, P1); PKH(_w0, P1, 0); \
    PVM(1, pa0, fa1l, fa1h); SUM2(1, P0, P1); PKH(_w1, P1, 2); \
    PVM(2, pa0, fa2l, fa2h); SUM2(2, P0, P1); PKH(_w2, P1, 4); \
    PVM(3, pa0, fa3l, fa3h); SUM2(3, P0, P1); PKH(_w3, P1, 6); { u32x4 _w = {_w0, _w1, _w2, _w3}; pa2 = *reinterpret_cast<bf16x8*>(&_w); PIN(pa2); } \
    LOADG(fa, 2, _vb); WAITL(8, fb); \
    PVM(0, pa1, fb0l, fb0h); SUM2(4, P0, P1); PKH(_w0, P1, 8); \
    PVM(1, pa1, fb1l, fb1h); SUM2(5, P0, P1); PKH(_w1, P1, 10); \
    PVM(2, pa1, fb2l, fb2h); SUM2(6, P0, P1); PKH(_w2, P1, 12); \
    PVM(3, pa1, fb3l, fb3h); SUM2(7, P0, P1); PKH(_w3, P1, 14); { u32x4 _w = {_w0, _w1, _w2, _w3}; pa3 = *reinterpret_cast<bf16x8*>(&_w); PIN(pa3); } l_acc += _s0 + _s1; PIN(l_acc); \
    LOADG(fb, 3, _vb); WAITL(8, fa); \
    PVM(0, pa2, fa0l, fa0h); \
    PVM(1, pa2, fa1l, fa1h); \
    PVM(2, pa2, fa2l, fa2h); \
    PVM(3, pa2, fa3l, fa3h); \
    WAITL(0, fb); \
    PVM(0, pa3, fb0l, fb0h); \
    PVM(1, pa3, fb1l, fb1h); \
    PVM(2, pa3, fb2l, fb2h); \
    PVM(3, pa3, fb3l, fb3h); } while (0)
    if (mm == 1) __builtin_amdgcn_s_setprio(1);
    RBAR();
#define CLAMPT(x) ((x) < NT ? (x) : NT - 1)
    for (int t = 0; t + 2 < NT; t += 2) {
        const int b0 = BOFF(t), b1 = BOFF(t + 1), b2 = BOFF(t + 2);
        s16x4 fa0l, fa0h, fa1l, fa1h, fa2l, fa2h, fa3l, fa3h, fb0l, fb0h, fb1l, fb1h, fb2l, fb2h, fb3l, fb3h;
        DMAK2(CLAMPT(t + 3), t + 3); DMAV2(CLAMPT(t + 2), t + 2); DMAK2(CLAMPT(t + 4), t + 4); DMAV2(CLAMPT(t + 3), t + 3);
        H1STEP(pA0, pA1, pB0, pB1, b1, vb0 + b0);
        H2STEP(vb0 + b0, pA0, pA1, pB0);
        H1STEP(pB0, pB1, pA0, pA1, b2, vb0 + b1);
        H2STEP(vb0 + b1, pB0, pB1, pA0);
        asm volatile("s_waitcnt vmcnt(0)" ::: "memory");
        RBAR();
    }
#undef CLAMPT
    {
        const int b0 = BOFF(NT - 2), b1 = BOFF(NT - 1);
        s16x4 fa0l, fa0h, fa1l, fa1h, fa2l, fa2h, fa3l, fa3h, fb0l, fb0h, fb1l, fb1h, fb2l, fb2h, fb3l, fb3h;
        H1STEP(pA0, pA1, pB0, pB1, b1, vb0 + b0);
        H2STEP(vb0 + b0, pA0, pA1, pB0);
        H1LAST(pB0, pB1, vb0 + b1);
        H2LAST(vb0 + b1, pB0, pB1);
    }
    asm volatile("s_waitcnt vmcnt(0)" ::: "memory");
    __builtin_amdgcn_s_setprio(0);
#undef PIN
#undef EXP4
#undef KFR
#undef H1STEP
#undef H1LAST
#undef H2LAST
#undef KRD
#undef WAITK
#undef PKN
#undef PKH
#undef EXP2E
#undef SWP
#undef MKPA
#undef QKM
#undef PVM
#undef SUM2
#undef LOADG
#undef PKV
#undef WAITL
#undef H2STEP
    float l_full; { auto rr = __builtin_amdgcn_permlane32_swap(__float_as_uint(l_acc), __float_as_uint(l_acc), false, false); l_full = __uint_as_float(rr[0]) + __uint_as_float(rr[1]); }
    const int bad = !(l_full < 1e30f);
    float* flg = (float*)(lds + 8 * SHM_V) + 512;
    if ((tid_l(wv) & 63) == 0) flg[wid] = __any(bad) ? 1.f : 0.f;
    __syncthreads();
    if (((flg[0] + flg[1]) + (flg[2] + flg[3])) + ((flg[4] + flg[5]) + (flg[6] + flg[7])) > 0.f) { __syncthreads(); attn_unit_exact(Pb, Yb, qrow0, b, h, NT, lamp, subg, lds, wv); return; }
    attn_epilogue(o, l_full, Pb, Yb, qrow0, h, lamp, subg, lds, li_l, wv);
#undef RBAR
#undef KVBASE
#undef DMAV2
#undef DMAK2
#undef BOFF
#undef QKTF
#undef EXPH
#undef PK4
#undef FINF
}
}

__device__ __forceinline__ void light_unit(CParams& p, int l, int ch, int part, char* lds, int wv) {
    const int tid = tid_l(wv), wid = tid >> 6, lane = tid & 63, r32 = lane & 31, hi = lane >> 5;
    const int row0 = ch * 128;
    const bf16_t* Pb = p.P; bf16_t* Yb = p.HY;
    const int rg = wid & 3, hh = wid >> 2, head = part * 2 + hh;
    const int sr_ = tid >> 2, sj = tid & 3;
    bf16x8 v[8];
    { const bf16_t* src = Pb + (size_t)(row0 + sr_) * DIN + COL_AV + sj * 64;
#pragma unroll
      for (int i = 0; i < 8; ++i) v[i] = *reinterpret_cast<const bf16x8*>(src + i * 8); }
    f32x4 gg[16];
    { const float* g = p.sgu_g + l * 256 + sj * 64;
#pragma unroll
      for (int i = 0; i < 16; ++i) gg[i] = *(const f32x4*)(g + i * 4); }
    const int cgp = tid & 15, rr = tid >> 4, cc = part * 128 + cgp * 8;
    const int s0 = row0 < NLAT ? (row0 & ~(SEQ - 1)) : NLAT + ((row0 - NLAT) & ~(CTXL - 1)), s1 = s0 + (row0 < NLAT ? SEQ : CTXL);
    bf16x8 cv[2][4];
#define CONV_LOAD(slot, i) do { const int t = row0 + rr + 32 * (i); const bf16_t* base = Pb + (size_t)t * DIN + cc; \
        cv[slot][0] = *reinterpret_cast<const bf16x8*>(base + COL_CC); cv[slot][1] = *reinterpret_cast<const bf16x8*>(base + COL_CB); \
        cv[slot][2] = (bf16x8){}; cv[slot][3] = (bf16x8){}; \
        if (t - 1 >= s0) cv[slot][2] = *reinterpret_cast<const bf16x8*>(base - DIN + COL_CC); \
        if (t + 1 < s1)  cv[slot][3] = *reinterpret_cast<const bf16x8*>(base + DIN + COL_CC); } while (0)
#define CONV_DO(slot, i) do { const int t = row0 + rr + 32 * (i); float y[8];        \
        _Pragma("unroll") for (int e = 0; e < 8; ++e) y[e] = bf2f(cv[slot][1][e]) * (w0[e] * bf2f(cv[slot][2][e]) + w1[e] * bf2f(cv[slot][0][e]) + w2[e] * bf2f(cv[slot][3][e]) + bb[e]); \
        u32x4 w = {cvtpk(y[0], y[1]), cvtpk(y[2], y[3]), cvtpk(y[4], y[5]), cvtpk(y[6], y[7])}; *(u32x4*)(Yb + (size_t)t * DM + YC + cc) = w; } while (0)
    CONV_LOAD(0, 0);
    float w0[8], w1[8], w2[8], bb[8];
    { const float* cw = p.conv_w + (size_t)l * 3 * 256 + cc; const float* cbv = p.conv_b + l * 256 + cc;
#pragma unroll
      for (int e = 0; e < 8; ++e) { w0[e] = cw[e]; w1[e] = cw[256 + e]; w2[e] = cw[512 + e]; bb[e] = cbv[e]; } }
    {   float ss = 0.f;
#pragma unroll
        for (int i = 0; i < 8; ++i)
#pragma unroll
            for (int e = 0; e < 8; ++e) { const float f = bf2f(v[i][e]); ss += f * f; }
        ss += shx(ss, lane, 1); ss += shx(ss, lane, 2);
        const float rstd = __builtin_amdgcn_rsqf(ss * (1.f / 256.f) + EPS);
        if ((sj >> 1) == part) {
            const int cbase = (sj & 1) * 64;
#pragma unroll
            for (int i = 0; i < 8; ++i) { const f32x4 g0 = gg[2 * i], g1 = gg[2 * i + 1];
                u32x4 w; w.x = cvtpk(bf2f(v[i][0]) * rstd * g0[0], bf2f(v[i][1]) * rstd * g0[1]); w.y = cvtpk(bf2f(v[i][2]) * rstd * g0[2], bf2f(v[i][3]) * rstd * g0[3]);
                w.z = cvtpk(bf2f(v[i][4]) * rstd * g1[0], bf2f(v[i][5]) * rstd * g1[1]); w.w = cvtpk(bf2f(v[i][6]) * rstd * g1[2], bf2f(v[i][7]) * rstd * g1[3]);
                *(u32x4*)(lds + (sr_ >> 6) * at::SHM_V + at::v_st(sr_ & 63, cbase + i * 8)) = w; }
        }
    }
    f32x4 wa[2][4], wb[2][4];
    { const float* W = p.sgu_w + ((size_t)(l * 4 + head) * 128 + rg * 32 + r32) * 128 + hi * 8;
#pragma unroll
      for (int tile = 0; tile < 2; ++tile)
#pragma unroll
          for (int ks = 0; ks < 4; ++ks) { wa[tile][ks] = *(const f32x4*)(W + tile * 64 + ks * 16); wb[tile][ks] = *(const f32x4*)(W + tile * 64 + ks * 16 + 4); } }
    bf16x8 gu[4];
#pragma unroll
    for (int jj = 0; jj < 4; ++jj) { const int c = tid + 512 * jj, row = c >> 4, col8 = (c & 15) * 8;
        gu[jj] = *reinterpret_cast<const bf16x8*>(Pb + (size_t)(row0 + row) * DIN + COL_AU + part * 128 + col8); }
    __syncthreads();
    CONV_DO(0, 0); CONV_LOAD(1, 1);
    {
        f32x16 o0 = {}, o1 = {};
        const int vb0 = (int)(uintptr_t)lds + at::v_rd_base(lane);
#pragma unroll
        for (int tile = 0; tile < 2; ++tile) {
            bf16x8 pa[4];
#pragma unroll
            for (int ks = 0; ks < 4; ++ks) { const f32x4 a = wa[tile][ks], bq = wb[tile][ks];
                u32x4 w = {cvtpk(a[0], a[1]), cvtpk(a[2], a[3]), cvtpk(bq[0], bq[1]), cvtpk(bq[2], bq[3])}; pa[ks] = *reinterpret_cast<bf16x8*>(&w); }
            if (hh == 0) { at::pv_one<0>(o0, vb0 + tile * at::SHM_V, pa[0], pa[1], pa[2], pa[3]); at::pv_one<1>(o1, vb0 + tile * at::SHM_V, pa[0], pa[1], pa[2], pa[3]); }
            else         { at::pv_one<2>(o0, vb0 + tile * at::SHM_V, pa[0], pa[1], pa[2], pa[3]); at::pv_one<3>(o1, vb0 + tile * at::SHM_V, pa[0], pa[1], pa[2], pa[3]); }
        }
        const float* bs = p.sgu_b + (size_t)(l * 4 + head) * 128 + rg * 32;
        float* mx = (float*)(lds + 2 * at::SHM_V) + ((hh * 4 + rg) * 2) * 1024 + lane;
#pragma unroll
        for (int q = 0; q < 4; ++q) { const f32x4 b4 = *(const f32x4*)(bs + 8 * q + 4 * hi);
#pragma unroll
            for (int j = 0; j < 4; ++j) { const int r = 4 * q + j; mx[r * 64] = o0[r] + b4[j]; mx[1024 + r * 64] = o1[r] + b4[j]; } }
    }
    __syncthreads();
    CONV_DO(1, 1); CONV_LOAD(0, 2);
    {
        const float* mbase = (const float*)(lds + 2 * at::SHM_V);
#pragma unroll
        for (int jj = 0; jj < 4; ++jj) { const int c = tid + 512 * jj, row = c >> 4, col8 = (c & 15) * 8;
            const int hq = col8 >> 6, d = col8 & 63, dd = d >> 5, rb = d & 31, rgq = row >> 5, within = row & 31, hiq = (within >> 2) & 1, r = (within & 3) + 4 * (within >> 3);
            const float* mp = mbase + (((hq * 4 + rgq) * 2 + dd) * 16 + r) * 64 + hiq * 32 + rb;
            const f32x4 m0 = *(const f32x4*)mp, m1 = *(const f32x4*)(mp + 4);
            u32x4 w = {cvtpk(m0[0] * bf2f(gu[jj][0]), m0[1] * bf2f(gu[jj][1])), cvtpk(m0[2] * bf2f(gu[jj][2]), m0[3] * bf2f(gu[jj][3])),
                       cvtpk(m1[0] * bf2f(gu[jj][4]), m1[1] * bf2f(gu[jj][5])), cvtpk(m1[2] * bf2f(gu[jj][6]), m1[3] * bf2f(gu[jj][7]))};
            *(u32x4*)(Yb + (size_t)(row0 + row) * DM + YA + part * 128 + col8) = w; }
    }
    CONV_DO(0, 2); CONV_LOAD(1, 3);
    CONV_DO(1, 3);
#undef CONV_LOAD
#undef CONV_DO
    __syncthreads();
}

__device__ __forceinline__ void sincos_f(float a, float& s, float& c) {
    const float k = rintf(a * 0.636619772f);
    float r = fmaf(-k, 1.5707962513e+00f, a); r = fmaf(-k, 7.5497894159e-08f, r); r = fmaf(-k, 5.3903029534e-15f, r);
    const float r2 = r * r;
    float sp = 2.7557319224e-6f; sp = fmaf(sp, r2, -1.9841269841e-4f); sp = fmaf(sp, r2, 8.3333333333e-3f); sp = fmaf(sp, r2, -1.6666666667e-1f); const float sr = fmaf(r * r2, sp, r);
    float cp = 2.4801587302e-5f; cp = fmaf(cp, r2, -1.3888888889e-3f); cp = fmaf(cp, r2, 4.1666666667e-2f); cp = fmaf(cp, r2, -0.5f); const float cr = fmaf(r2, cp, 1.0f);
    const int q = ((int)k) & 3;
    s = (q == 0) ? sr : (q == 1) ? cr : (q == 2) ? -sr : -cr;
    c = (q == 0) ? cr : (q == 1) ? -sr : (q == 2) ? -cr : sr;
}

__device__ __forceinline__ void convert_weights(CParams& p, int l, int first, int stride, char* lds, int wv) {
    const int tid = tid_l(wv);
    float* T = (float*)lds;
    const float* srcI = p.w_in + (size_t)l * DM * DIN; bf16_t* dstI = p.WinT + (size_t)l * DIN * DM;
    const float* srcO = p.w_out + (size_t)l * DM * DM; bf16_t* dstO = p.WoutT + (size_t)l * DM * DM;
    for (int u0 = first; u0 < 1216; u0 += 4 * stride) {
        f32x4 va[4], vb[4]; bf16_t* dq[4];
#pragma unroll
        for (int q = 0; q < 4; ++q) { const int u = u0 + q * stride; va[q] = (f32x4){0.f, 0.f, 0.f, 0.f}; vb[q] = va[q]; dq[q] = nullptr;
            if (u < 1216) { const float* src; bf16_t* dst; int N, kt, nt;
                int ntd;
                if (u < 960) { kt = u / 60; nt = u % 60; src = srcI; dst = dstI; N = DIN;
                    const int blk = nt >> 1, nb = blk == 1 ? 4 : blk == 4 ? 1 : blk == 23 ? 28 : blk == 28 ? 23 : blk == 25 ? 26 : blk == 26 ? 25 : blk; ntd = nb * 2 + (nt & 1); }
                else { const int v = u - 960; kt = v / 16; nt = v % 16; src = srcO; dst = dstO; N = DM; ntd = nt; }
                const int row = tid >> 3, cs = (tid & 7) * 8; const float* sp = src + (size_t)(kt * 64 + row) * N + nt * 64 + cs;
                va[q] = *(const f32x4*)sp; vb[q] = *(const f32x4*)(sp + 4);
                dq[q] = dst + (size_t)(ntd * 64 + (tid >> 3)) * DM + kt * 64 + (tid & 7) * 8; } }
#pragma unroll
        for (int q = 0; q < 4; ++q) { const int row = tid >> 3, cs = (tid & 7) * 8; float* t = T + q * 4160 + row * 65 + cs;
            t[0] = va[q][0]; t[1] = va[q][1]; t[2] = va[q][2]; t[3] = va[q][3]; t[4] = vb[q][0]; t[5] = vb[q][1]; t[6] = vb[q][2]; t[7] = vb[q][3]; }
        __syncthreads();
#pragma unroll
        for (int q = 0; q < 4; ++q) { const int n = tid >> 3, kc = (tid & 7) * 8; const float* t = T + q * 4160 + kc * 65 + n;
            if (dq[q]) { u32x4 w = {cvtpk(t[0], t[65]), cvtpk(t[130], t[195]), cvtpk(t[260], t[325]), cvtpk(t[390], t[455])}; *(u32x4*)dq[q] = w; } }
        __syncthreads();
    }
}

__device__ __forceinline__ void phase_prep(CParams& p, char* lds, int wv) {
    const int tid = tid_l(wv), bid = bid_l();
    float* S = (float*)(lds + 4 * 16640);
    float* R = (float*)(lds + 4 * 16640 + 12288);
    convert_weights(p, 0, bid, (int)gridDim.x, lds, wv);
    if (bid < 192) {
        for (int i = tid; i < 3072; i += 512) { const int cnd = i >> 10, k = i & 1023; const float v = cnd < 2 ? p.c[cnd * 1024 + k] : p.c_ctx[k]; S[i] = v / (1.f + expf(-v)); }
        __syncthreads();
        for (int u = bid; u < 192; u += gridDim.x) {
            const int l = u / 48, c0 = (u % 48) * 64, j4 = (tid & 15) * 4, kg = tid >> 4;
            const float* w = p.w_mod + (size_t)l * DM * 3072 + c0 + j4;
            f32x4 a0 = {0.f, 0.f, 0.f, 0.f}, a1 = a0, a2 = a0;
#pragma unroll 8
            for (int k = kg; k < 1024; k += 32) { const f32x4 wv4 = *(const f32x4*)(w + (size_t)k * 3072); a0 += wv4 * S[k]; a1 += wv4 * S[1024 + k]; a2 += wv4 * S[2048 + k]; }
            *(f32x4*)(R + (0 * 32 + kg) * 64 + j4) = a0; *(f32x4*)(R + (1 * 32 + kg) * 64 + j4) = a1; *(f32x4*)(R + (2 * 32 + kg) * 64 + j4) = a2;
            __syncthreads();
            if (tid < 192) { const int cnd = tid >> 6, jj = tid & 63; float sm = 0.f;
#pragma unroll
                for (int g = 0; g < 32; ++g) sm += R[(cnd * 32 + g) * 64 + jj];
                p.mod[(size_t)(l * 3 + cnd) * 3072 + c0 + jj] = sm + p.b_mod[l * 3072 + c0 + jj]; }
            __syncthreads();
        }
    }
    if (bid == (int)gridDim.x - 1) {
        for (int i = tid; i < 2048; i += 512) { const int pos = i >> 4, pp = i & 15;
            const float inv = __builtin_amdgcn_exp2f(-(float)pp * 0.830482023721841f);
            float s, c; sincos_f((float)pos * inv, s, c); p.rope[i] = c; p.rope[2048 + i] = s; }
        if (tid < DEPTH) { float d1 = 0.f, d2 = 0.f;
            for (int k = 0; k < 64; ++k) { d1 += p.lq1[tid * 64 + k] * p.lk1[tid * 64 + k]; d2 += p.lq2[tid * 64 + k] * p.lk2[tid * 64 + k]; }
            const float li = 0.8f - 0.6f * expf(-0.3f * (float)tid); p.lam[tid] = expf(d1) - expf(d2) + li; p.lam[DEPTH + tid] = 1.f - li; }
    }
}

__device__ __forceinline__ float wave_sum(float v, int lane) {
    v = row16_sum(v); v += shx(v, lane, 16); v += shx(v, lane, 32); return v;
}
__device__ __forceinline__ void phase_norm(CParams& p, int l, int wv) {
    const int tid = tid_l(wv), wid = tid >> 6, lane = tid & 63, bid = bid_l();
    const float* modl = p.mod + (size_t)l * 3 * 3072; const float* g = p.norm_g + l * DM;
    f32x4 ga[4], sb[4]; int cur = -1;
    const int stride = (int)gridDim.x * 8;
    f32x4 v[4], vn[4];
#define XROW(r) ((l == 0) ? ((r) < NLAT ? p.x + (size_t)(r) * DM : p.ctx + (size_t)((r) - NLAT) * DM) : ((r) < NLAT ? p.xlat + (size_t)(r) * DM : p.xctx + (size_t)((r) - NLAT) * DM))
    int row = bid * 8 + wid;
    if (row < NROW) { const float* xr = XROW(row);
#pragma unroll
        for (int i = 0; i < 4; ++i) v[i] = *(const f32x4*)(xr + i * 256 + lane * 4); }
    for (; row < NROW; row += stride) {
        const int nrow = row + stride;
        if (nrow < NROW) { const float* xr = XROW(nrow);
#pragma unroll
            for (int i = 0; i < 4; ++i) vn[i] = *(const f32x4*)(xr + i * 256 + lane * 4); }
        const int cnd = row < SEQ ? 0 : row < NLAT ? 1 : 2;
        float ss = 0.f;
#pragma unroll
        for (int i = 0; i < 4; ++i) ss += v[i][0] * v[i][0] + v[i][1] * v[i][1] + v[i][2] * v[i][2] + v[i][3] * v[i][3];
        if (cnd != cur) { cur = cnd; const float* sh = modl + cnd * 3072; const float* sc = sh + 1024;
#pragma unroll
            for (int i = 0; i < 4; ++i) { const int col = i * 256 + lane * 4; ga[i] = *(const f32x4*)(g + col) * (*(const f32x4*)(sc + col) + 1.f); sb[i] = *(const f32x4*)(sh + col); } }
        ss = wave_sum(ss, lane); const float rstd = __builtin_amdgcn_rsqf(ss * (1.f / 1024.f) + EPS);
#pragma unroll
        for (int i = 0; i < 4; ++i) { const int col = i * 256 + lane * 4;
            const f32x4 o = v[i] * rstd * ga[i] + sb[i];
            u32x2 w = {cvtpk(o[0], o[1]), cvtpk(o[2], o[3])}; *(u32x2*)(p.HY + (size_t)row * DM + col) = w; }
#pragma unroll
        for (int i = 0; i < 4; ++i) v[i] = vn[i];
    }
#undef XROW
}
__device__ __forceinline__ void phase_final(CParams& p, int wv) {
    const int tid = tid_l(wv), wid = tid >> 6, lane = tid & 63, bid = bid_l();
    f32x4 fg[4];
#pragma unroll
    for (int i = 0; i < 4; ++i) fg[i] = *(const f32x4*)(p.final_g + i * 256 + lane * 4);
    const int stride = (int)gridDim.x * 8;
    f32x4 v[4], vn[4];
    int row = bid * 8 + wid;
    if (row < NLAT) { const float* xr = p.xlat + (size_t)row * DM;
#pragma unroll
        for (int i = 0; i < 4; ++i) v[i] = *(const f32x4*)(xr + i * 256 + lane * 4); }
    for (; row < NLAT; row += stride) {
        const int nrow = row + stride;
        if (nrow < NLAT) { const float* xr = p.xlat + (size_t)nrow * DM;
#pragma unroll
            for (int i = 0; i < 4; ++i) vn[i] = *(const f32x4*)(xr + i * 256 + lane * 4); }
        float* xw = p.xlat + (size_t)row * DM;
        float ss = 0.f;
#pragma unroll
        for (int i = 0; i < 4; ++i) ss += v[i][0] * v[i][0] + v[i][1] * v[i][1] + v[i][2] * v[i][2] + v[i][3] * v[i][3];
        ss = wave_sum(ss, lane); const float rstd = __builtin_amdgcn_rsqf(ss * (1.f / 1024.f) + EPS);
#pragma unroll
        for (int i = 0; i < 4; ++i) { const int col = i * 256 + lane * 4; *(f32x4*)(xw + col) = v[i] * rstd * fg[i]; }
#pragma unroll
        for (int i = 0; i < 4; ++i) v[i] = vn[i];
    }
}

__device__ __forceinline__ void phase_mix(CParams& p, int l, char* lds, int wv) {
    const int c = bid_l(), G = gridDim.x;
    const float* subg = p.subln_g + l * 128;
    const int nlat_u = (512 - c + G - 1) / G;
    for (int k = 0; k <= nlat_u; ++k) {
        int qrow0, b, h, NT;
        if (k < nlat_u) { const int u = c + k * G, bh = u & 7, qb = u >> 3; b = bh >> 2; h = bh & 3; qrow0 = b * SEQ + qb * 128; NT = 132; }
        else { const int u = (c + G - 16) % G; if (l == DEPTH - 1 || u >= 16) break; const int bh = u & 7, qb = u >> 3; b = bh >> 2; h = bh & 3; qrow0 = NLAT + b * CTXL + qb * 128; NT = 4; }
        at::attn_unit(p.P, p.HY, qrow0, b, h, NT, p.lam + l, subg, lds, (PG8_LAS unsigned char*)lds, wv);
    }
    const int nlight = (l < DEPTH - 1 ? NROW / 128 : NLAT / 128) * 2;
    const bool give = (l < DEPTH - 1) && G >= 48;
    int u = c; bool extra_done = false;
    for (;;) {
        int uu;
        if (u < nlight) { uu = u; u += G; if (give && uu >= 16 && uu < 32) continue; }
        else if (!extra_done) { extra_done = true; if (!(give && c >= 32 && c < 48)) break; uu = c - 16; }
        else break;
        light_unit(p, l, uu >> 1, uu & 1, lds, wv);
    }
}

__device__ __forceinline__ void ctx_outproj(CParams& p, int l, char* lds, int wv) {
    const int tid = tid_l(wv), wid = tid >> 6, lane = tid & 63, r32 = lane & 31, hi = lane >> 5;
    const float* xsrc = l == 0 ? p.ctx : p.xctx; const float* gate = p.mod + (size_t)(l * 3 + 2) * 3072 + 2048;
    float* part = (float*)lds;
    for (int u = bid_l(); u < 256; u += gridDim.x) {
        const int row0 = (u >> 4) * 32, col0 = (u & 15) * 64;
        const bf16_t* A = p.HY + (size_t)(NLAT + row0 + r32) * DM + wid * 128 + hi * 8;
        const bf16_t* B = p.WoutT + (size_t)l * DM * DM + (size_t)(col0 + r32) * DM + wid * 128 + hi * 8;
        f32x16 acc0 = {}, acc1 = {};
#pragma unroll
        for (int ks = 0; ks < 8; ++ks) {
            const bf16x8 a = *reinterpret_cast<const bf16x8*>(A + ks * 16), b0 = *reinterpret_cast<const bf16x8*>(B + ks * 16), b1 = *reinterpret_cast<const bf16x8*>(B + 32 * DM + ks * 16);
            acc0 = __builtin_amdgcn_mfma_f32_32x32x16_bf16(a, b0, acc0, 0, 0, 0); acc1 = __builtin_amdgcn_mfma_f32_32x32x16_bf16(a, b1, acc1, 0, 0, 0); }
#pragma unroll
        for (int r = 0; r < 16; ++r) { part[wid * 2048 + r * 64 + lane] = acc0[r]; part[wid * 2048 + 1024 + r * 64 + lane] = acc1[r]; }
        __syncthreads();
        float xs4[4], gt4[4];
#pragma unroll
        for (int j = 0; j < 4; ++j) { const int e = tid + 512 * j, cb = e >> 10, r = (e >> 6) & 15, ln = e & 63, row = row0 + at::crow(r, ln >> 5), col = col0 + cb * 32 + (ln & 31);
            xs4[j] = xsrc[(size_t)row * DM + col]; gt4[j] = gate[col]; }
#pragma unroll
        for (int j = 0; j < 4; ++j) { const int e = tid + 512 * j; float sum = 0.f;
#pragma unroll
            for (int w = 0; w < 8; ++w) sum += part[w * 2048 + e];
            const int cb = e >> 10, r = (e >> 6) & 15, ln = e & 63, row = row0 + at::crow(r, ln >> 5), col = col0 + cb * 32 + (ln & 31);
            p.xctx[(size_t)row * DM + col] = xs4[j] + gt4[j] * sum; }
        __syncthreads();
    }
}

#define XB_TMO      128
#define XB_XCNT(j)  (256  + 64 * (j))
#define XB_XSUB(j)  (1280 + 64 * (j))
#define XB_XGEN(j)  (2304 + 64 * (j))
#define XB_TOP      3328
#define XB_TOPGEN   3392
#define XB_WORDS    3456
#define XB_SPIN_CAP (1u << 18)
__device__ __forceinline__ unsigned xb_ld(unsigned* p)              { return __hip_atomic_load(p, __ATOMIC_RELAXED, __HIP_MEMORY_SCOPE_AGENT); }
__device__ __forceinline__ unsigned xb_add(unsigned* p, unsigned v) { return __hip_atomic_fetch_add(p, v, __ATOMIC_RELAXED, __HIP_MEMORY_SCOPE_AGENT); }
__device__ __forceinline__ unsigned xb_xcc_id() { return (unsigned)__builtin_amdgcn_s_getreg((3 << 11) | 20) & 0xFu; }
#define XB_SPIN(cond, bar) do { unsigned _sp = 0; while (cond) { __builtin_amdgcn_s_sleep(1); \
    if ((++_sp & 255u) == 0u) { if (xb_ld(&(bar)[XB_TMO])) break; if (_sp > XB_SPIN_CAP) { atomicAdd(&(bar)[XB_TMO], 1u); break; } } } } while (0)
__device__ __forceinline__ void xb_complete(unsigned* bar, unsigned x, unsigned& nloc, unsigned& nx) {
    const unsigned G = gridDim.x;
    unsigned sum, cnt, mine, sp = 0u;
    for (;;) {
        sum = 0u; cnt = 0u; mine = 0u;
#pragma unroll
        for (unsigned j = 0; j < 16; ++j) { const unsigned c = xb_ld(&bar[XB_XCNT(j)]); sum += c; cnt += (c > 0u) ? 1u : 0u; mine = (j == x) ? c : mine; }
        if (sum == G) break;
        __builtin_amdgcn_s_sleep(1);
        if ((++sp & 255u) == 0u) { if (xb_ld(&bar[XB_TMO])) break; if (sp > XB_SPIN_CAP) { atomicAdd(&bar[XB_TMO], 1u); break; } }
    }
    nloc = mine > 0u ? mine : 1u; nx = cnt > 0u ? cnt : 1u;
}
__device__ __forceinline__ void grid_bar(unsigned* bar, volatile PG8_LAS unsigned* st, int wv) {
    asm volatile("s_waitcnt vmcnt(0)" ::: "memory");
    __syncthreads();
    if (tid_l(wv) == 0) {
        __builtin_amdgcn_s_waitcnt(0);
        const unsigned x = xb_xcc_id();
        unsigned nloc = st[0], nx = st[1];
        if (nloc == 0u) { xb_complete(bar, x, nloc, nx); st[0] = nloc; st[1] = nx; }
        const unsigned old = xb_add(&bar[XB_XSUB(x)], 1u);
        const unsigned gen = old / nloc;
        if (old + 1u == (gen + 1u) * nloc) {
            __builtin_amdgcn_fence(__ATOMIC_RELEASE, "agent");
            asm volatile("s_waitcnt vmcnt(0)" ::: "memory");
            const unsigned og = xb_add(&bar[XB_TOP], 1u);
            const unsigned tg = og / nx;
            if (og + 1u == (tg + 1u) * nx) xb_add(&bar[XB_TOPGEN], 1u);
            else XB_SPIN(xb_ld(&bar[XB_TOPGEN]) == tg, bar);
            __builtin_amdgcn_fence(__ATOMIC_ACQUIRE, "agent");
            xb_add(&bar[XB_XGEN(x)], 1u);
            asm volatile("s_waitcnt vmcnt(0)" ::: "memory");
        } else {
            XB_SPIN(xb_ld(&bar[XB_XGEN(x)]) == gen, bar);
            __builtin_amdgcn_fence(__ATOMIC_ACQUIRE, "agent");
            asm volatile("s_waitcnt vmcnt(0)" ::: "memory");
        }
    }
    __syncthreads();
}

__global__ __launch_bounds__(512, 2) void mega(Params p_unused) {
    extern __shared__ __attribute__((aligned(16))) unsigned char shm[];
    const int wv = __builtin_amdgcn_readfirstlane((int)(threadIdx.x >> 6));
    volatile PG8_LAS unsigned* xst = (volatile PG8_LAS unsigned*)((PG8_LAS unsigned char*)shm + 131072 + 2048 + 64);
    {
        CParams& p = params_l();
        if (tid_l(wv) == 0) { xst[0] = 0u; xst[1] = 0u; (void)xb_add(&p.bar[XB_XCNT(xb_xcc_id())], 1u); }
        phase_prep(p, (char*)shm, wv);
        if (gridDim.x == 0x7fffffffu) cg::this_grid().sync();
        grid_bar(p.bar, xst, wv);
    }
#pragma clang loop unroll(disable)
    for (int l = 0; l < DEPTH; ++l) {
        { CParams& p = params_l(); phase_norm(p, l, wv); grid_bar(p.bar, xst, wv); }
        { CParams& p = params_l();
          pg8::Gemm g{p.HY, p.WinT + (size_t)l * DIN * DM, NROW, DIN, DM};
          pg8::StaticOrder S; S.init(g.M, g.N, (int)gridDim.x, bid_l());
          EpiIn E{p.P, p.rope};
          pg8::gemm_phase<EpiIn, pg8::StaticOrder>((PG8_LAS unsigned char*)shm, g, S, E, wv);
          if (l < DEPTH - 1) {
              const int Gi = (int)gridDim.x, nwg = (NROW / 256) * (DIN / 256), maxu = (nwg + Gi - 1) / Gi, nidle = Gi * maxu - nwg, c = bid_l();
              if (nidle == 0) convert_weights(p, l + 1, c, Gi, (char*)shm, wv);
              else if (c >= Gi - nidle) convert_weights(p, l + 1, c - (Gi - nidle), nidle, (char*)shm, wv);
          }
          grid_bar(p.bar, xst, wv); }
        { CParams& p = params_l(); phase_mix(p, l, (char*)shm, wv); grid_bar(p.bar, xst, wv); }
        { CParams& p = params_l();
          pg8::Gemm g{p.HY, p.WoutT + (size_t)l * DM * DM, NLAT, DM, DM};
          pg8::StaticOrder S; S.init(g.M, g.N, (int)gridDim.x, bid_l());
          EpiOut E{l == 0 ? p.x : p.xlat, l == 0 ? p.ctx : p.xctx, p.xlat, p.xctx, p.mod + (size_t)l * 3 * 3072};
          pg8::gemm_phase<EpiOut, pg8::StaticOrder>((PG8_LAS unsigned char*)shm, g, S, E, wv);
          if (l < DEPTH - 1) ctx_outproj(p, l, (char*)shm, wv);
          grid_bar(p.bar, xst, wv); }
    }
    { CParams& p = params_l(); phase_final(p, wv); }
}

constexpr size_t LDS_BYTES = 131072 + 2048 + 128;
static inline size_t al256(size_t x) { return (x + 255) / 256 * 256; }
extern "C" void kernel_launch(void* const* d_in, const int* in_sizes, int n_in, void* d_out, int out_size, void* d_ws, size_t ws_size, hipStream_t stream) {
    static int grid_blocks = 0;
    if (!grid_blocks) {
        int dev = 0, cus = 0, per_cu = 0;
        hipGetDevice(&dev);
        hipDeviceGetAttribute(&cus, hipDeviceAttributeMultiprocessorCount, dev);
        if (hipFuncSetAttribute((const void*)mega, hipFuncAttributeMaxDynamicSharedMemorySize, (int)LDS_BYTES) != hipSuccess) fprintf(stderr, "kernel_launch: hipFuncSetAttribute failed\n");
        hipOccupancyMaxActiveBlocksPerMultiprocessor(&per_cu, mega, 512, LDS_BYTES);
        if (per_cu < 1) per_cu = 1;
        if (cus < 1) cus = 256;
        grid_blocks = cus * (per_cu > 1 ? 1 : per_cu);
    }
    Params p{};
    p.x = (const float*)d_in[0]; p.c = (const float*)d_in[1]; p.ctx = (const float*)d_in[2]; p.c_ctx = (const float*)d_in[3]; p.w_mod = (const float*)d_in[4]; p.b_mod = (const float*)d_in[5];
    p.norm_g = (const float*)d_in[6]; p.w_in = (const float*)d_in[7]; p.w_out = (const float*)d_in[8]; p.sgu_g = (const float*)d_in[9]; p.sgu_w = (const float*)d_in[10]; p.sgu_b = (const float*)d_in[11];
    p.lq1 = (const float*)d_in[12]; p.lk1 = (const float*)d_in[13]; p.lq2 = (const float*)d_in[14]; p.lk2 = (const float*)d_in[15]; p.subln_g = (const float*)d_in[16];
    p.conv_w = (const float*)d_in[17]; p.conv_b = (const float*)d_in[18]; p.final_g = (const float*)d_in[19];
    char* w = (char*)d_ws; size_t off = 0;
    p.xlat = (float*)d_out;
    p.xctx = (float*)(w + off); off += al256((size_t)NCTX * DM * 4);
    p.WinT = (bf16_t*)(w + off); off += al256((size_t)DEPTH * DIN * DM * 2);
    p.WoutT = (bf16_t*)(w + off); off += al256((size_t)DEPTH * DM * DM * 2);
    p.mod = (float*)(w + off); off += al256((size_t)DEPTH * 3 * 3072 * 4);
    p.rope = (float*)(w + off); off += al256(4096 * 4);
    p.lam = (float*)(w + off); off += 256;
    p.bar = (unsigned*)(w + off); off += al256(XB_WORDS * 4);
    p.HY = (bf16_t*)(w + off); off += al256((size_t)NROW * DM * 2);
    p.P = (bf16_t*)(w + off); off += al256((size_t)NROW * DIN * 2);
    if (off > ws_size) { fprintf(stderr, "kernel_launch: workspace too small: need %zu have %zu\n", off, ws_size); return; }
    if (hipMemsetAsync(p.bar, 0, XB_WORDS * 4, stream) != hipSuccess) fprintf(stderr, "kernel_launch: hipMemsetAsync failed\n");
    void* args[] = {&p};
    hipError_t e = hipLaunchCooperativeKernel((const void*)mega, dim3(grid_blocks), dim3(512), args, LDS_BYTES, stream);
    if (e != hipSuccess) fprintf(stderr, "kernel_launch: cooperative launch failed: %s (grid %d)\n", hipGetErrorString(e), grid_blocks);
}
```
